# Optimizing an MI355X kernel written in HIP

```python
import math
import jax, jax.numpy as jnp
from jax import lax
import numpy as np

D_MODEL = 1024
BATCH = 16
SEQ = 2048
DEPTH = 1

HEAD_DIM = 64
DIFF_HEADS = 4
DIFF_VDIM = 2 * HEAD_DIM
DIL_HEADS = 8
DIL_CONFIGS = ((128, 1), (512, 4), (2048, 16))
DIFF_WIDTH = DIFF_HEADS * DIFF_VDIM
DIL_WIDTH = DIL_HEADS * HEAD_DIM
MIX_WIDTH = DIFF_WIDTH + DIL_WIDTH
DIFF_QK_COLS = DIFF_HEADS * 2 * HEAD_DIM
IN_COLS = 2 * DIFF_QK_COLS + DIFF_WIDTH + 3 * DIL_WIDTH
D_FF = 2816
ROPE_THETA = 500000.0
ROPE_DIM = HEAD_DIM // 4
BLOCK = 128
EPS = 1e-5

kernel_name = "hymba_diff_dilated_macaron"


def rmsnorm(x, g):
    xf = x.astype(jnp.float32)
    y = xf * lax.rsqrt(jnp.mean(xf * xf, axis=-1, keepdims=True) + EPS)
    return (y * g.astype(jnp.float32)).astype(x.dtype)


def swiglu(x, w_gate, w_up, w_down):
    return (jax.nn.silu(x @ w_gate) * (x @ w_up)) @ w_down


def rope_partial(x, positions):
    half = ROPE_DIM // 2
    inv = jnp.exp(-math.log(ROPE_THETA) * jnp.arange(half, dtype=jnp.float32) * 2.0 / ROPE_DIM)
    ang = positions.astype(jnp.float32)[:, :, None, None] * inv
    cos, sin = jnp.cos(ang), jnp.sin(ang)
    xf = x.astype(jnp.float32)
    x1, x2 = xf[..., :half], xf[..., half:ROPE_DIM]
    out = jnp.concatenate([x1 * cos - x2 * sin, x2 * cos + x1 * sin, xf[..., ROPE_DIM:]], axis=-1)
    return out.astype(x.dtype)


def diff_attention(q, k, v, lam):
    B, S = q.shape[0], q.shape[1]
    nb = S // BLOCK
    scale = HEAD_DIM ** -0.5
    qb = q.reshape(B, nb, BLOCK, *q.shape[2:]).transpose(1, 0, 2, 3, 4, 5)
    kpos = jnp.arange(S)

    def one_block(args):
        qblk, bi = args
        s = jnp.einsum('bqhcd,bkhcd->bhcqk', qblk, k).astype(jnp.float32) * scale
        qpos = bi * BLOCK + jnp.arange(BLOCK)
        mask = kpos[None, :] <= qpos[:, None]
        p = jax.nn.softmax(jnp.where(mask, s, -jnp.inf), axis=-1)
        attn = p[:, :, 0] - lam * p[:, :, 1]
        return jnp.einsum('bhqk,bkhe->bqhe', attn.astype(v.dtype), v)

    out = lax.map(one_block, (qb, jnp.arange(nb)))
    return out.transpose(1, 0, 2, 3, 4).reshape(B, S, q.shape[2], v.shape[-1])


def dilated_branch(q, k, v, window, dilation):
    B, S, H, dh = q.shape
    L = S // dilation
    w = window // dilation
    Lp = -(-L // BLOCK) * BLOCK
    nb = Lp // BLOCK
    n_prev = -(-w // BLOCK)
    KB = (n_prev + 1) * BLOCK
    scale = dh ** -0.5

    def to_sub(t):
        return t.reshape(B, L, dilation, H, dh).transpose(0, 2, 3, 1, 4)

    qs = jnp.pad(to_sub(q), ((0, 0), (0, 0), (0, 0), (0, Lp - L), (0, 0)))
    qb = qs.reshape(B, dilation, H, nb, BLOCK, dh)

    def band(t):
        tp = jnp.pad(to_sub(t), ((0, 0), (0, 0), (0, 0), (n_prev * BLOCK, Lp - L), (0, 0)))
        tb = tp.reshape(B, dilation, H, nb + n_prev, BLOCK, dh)
        return jnp.concatenate([tb[:, :, :, j:j + nb] for j in range(n_prev + 1)], axis=4)

    kb, vb = band(k), band(v)
    s = jnp.einsum('brhnqd,brhnkd->brhnqk', qb, kb).astype(jnp.float32) * scale
    q_off = jnp.arange(BLOCK)[:, None]
    k_off = jnp.arange(KB)[None, :]
    dist = q_off + n_prev * BLOCK - k_off
    kpos = jnp.arange(nb)[:, None, None] * BLOCK - n_prev * BLOCK + k_off[None]
    valid = (dist >= 0) & (dist <= w) & (kpos >= 0)
    s = jnp.where(valid, s, -jnp.inf)
    m = jnp.max(s, axis=-1, keepdims=True)
    p = jnp.exp(s - m)
    denom = jnp.sum(p, axis=-1)
    o = jnp.einsum('brhnqk,brhnkd->brhnqd', p.astype(v.dtype), vb).astype(jnp.float32) / denom[..., None]
    lse = m[..., 0] + jnp.log(denom)
    o = o.reshape(B, dilation, H, Lp, dh)[:, :, :, :L].transpose(0, 3, 1, 2, 4).reshape(B, S, H, dh)
    lse = lse.reshape(B, dilation, H, Lp)[..., :L].transpose(0, 3, 1, 2).reshape(B, S, H)
    return o, lse


def dilated_attention(q, k, v):
    outs, lses = [], []
    for window, dilation in DIL_CONFIGS:
        o, l = dilated_branch(q, k, v, window, dilation)
        outs.append(o)
        lses.append(l)
    wts = jax.nn.softmax(jnp.stack(lses, axis=0), axis=0)
    out = jnp.sum(wts[..., None] * jnp.stack(outs, axis=0), axis=0)
    return out.astype(q.dtype)


def setup_inputs(seed: int = 0) -> dict:
    key = jax.random.key(seed)
    ks = jax.random.split(key, 20)
    f32 = jnp.float32

    def nrm(k, shape, scale):
        return jax.random.normal(k, shape, f32) * scale

    def gain(k, shape):
        return 1.0 + 0.02 * jax.random.normal(k, shape, f32)

    return {
        "x": jax.random.normal(ks[0], (BATCH, SEQ, D_MODEL), f32),
        "positions": jnp.broadcast_to(jnp.arange(SEQ, dtype=jnp.int32), (BATCH, SEQ)),
        "ffn1_norm": gain(ks[1], (DEPTH, D_MODEL)),
        "ffn1_gate": nrm(ks[2], (DEPTH, D_MODEL, D_FF), D_MODEL ** -0.5),
        "ffn1_up": nrm(ks[3], (DEPTH, D_MODEL, D_FF), D_MODEL ** -0.5),
        "ffn1_down": nrm(ks[4], (DEPTH, D_FF, D_MODEL), D_FF ** -0.5),
        "mix_norm": gain(ks[5], (DEPTH, D_MODEL)),
        "w_in": nrm(ks[6], (DEPTH, D_MODEL, IN_COLS), D_MODEL ** -0.5),
        "lambda_q1": nrm(ks[7], (DEPTH, HEAD_DIM), 0.1),
        "lambda_k1": nrm(ks[8], (DEPTH, HEAD_DIM), 0.1),
        "lambda_q2": nrm(ks[9], (DEPTH, HEAD_DIM), 0.1),
        "lambda_k2": nrm(ks[10], (DEPTH, HEAD_DIM), 0.1),
        "subln_gain": gain(ks[11], (DEPTH, DIFF_VDIM)),
        "w_out": nrm(ks[12], (DEPTH, MIX_WIDTH, D_MODEL), MIX_WIDTH ** -0.5),
        "ffn2_norm": gain(ks[13], (DEPTH, D_MODEL)),
        "ffn2_gate": nrm(ks[14], (DEPTH, D_MODEL, D_FF), D_MODEL ** -0.5),
        "ffn2_up": nrm(ks[15], (DEPTH, D_MODEL, D_FF), D_MODEL ** -0.5),
        "ffn2_down": nrm(ks[16], (DEPTH, D_FF, D_MODEL), D_FF ** -0.5),
        "final_norm": gain(ks[17], (D_MODEL,)),
    }


def reference(x, positions, ffn1_norm, ffn1_gate, ffn1_up, ffn1_down, mix_norm, w_in,
              lambda_q1, lambda_k1, lambda_q2, lambda_k2, subln_gain, w_out,
              ffn2_norm, ffn2_gate, ffn2_up, ffn2_down, final_norm):
    B, S, _ = x.shape
    for l in range(DEPTH):
        x = x + 0.5 * swiglu(rmsnorm(x, ffn1_norm[l]), ffn1_gate[l], ffn1_up[l], ffn1_down[l])

        h = rmsnorm(x, mix_norm[l])
        proj = h @ w_in[l]
        splits = np.cumsum([DIFF_QK_COLS, DIFF_QK_COLS, DIFF_WIDTH, DIL_WIDTH, DIL_WIDTH]).tolist()
        dq, dk, dv, gq, gk, gv = jnp.split(proj, splits, axis=-1)

        lambda_init = 0.8 - 0.6 * math.exp(-0.3 * l)
        lam = (jnp.exp(jnp.sum(lambda_q1[l].astype(jnp.float32) * lambda_k1[l].astype(jnp.float32)))
               - jnp.exp(jnp.sum(lambda_q2[l].astype(jnp.float32) * lambda_k2[l].astype(jnp.float32)))
               + lambda_init)
        dq = rope_partial(dq.reshape(B, S, DIFF_HEADS * 2, HEAD_DIM), positions).reshape(B, S, DIFF_HEADS, 2, HEAD_DIM)
        dk = rope_partial(dk.reshape(B, S, DIFF_HEADS * 2, HEAD_DIM), positions).reshape(B, S, DIFF_HEADS, 2, HEAD_DIM)
        dv = dv.reshape(B, S, DIFF_HEADS, DIFF_VDIM)
        a_out = diff_attention(dq, dk, dv, lam)
        a_out = rmsnorm(a_out, subln_gain[l]) * (1.0 - lambda_init)
        a_out = a_out.reshape(B, S, DIFF_WIDTH)

        gq = rope_partial(gq.reshape(B, S, DIL_HEADS, HEAD_DIM), positions)
        gk = rope_partial(gk.reshape(B, S, DIL_HEADS, HEAD_DIM), positions)
        gv = gv.reshape(B, S, DIL_HEADS, HEAD_DIM)
        b_out = dilated_attention(gq, gk, gv).reshape(B, S, DIL_WIDTH)

        x = x + jnp.concatenate([a_out, b_out], axis=-1) @ w_out[l]

        x = x + 0.5 * swiglu(rmsnorm(x, ffn2_norm[l]), ffn2_gate[l], ffn2_up[l], ffn2_down[l])
    return rmsnorm(x, final_norm)
```

```cpp
#include <hip/hip_runtime.h>
#include <hip/hip_cooperative_groups.h>
#include <cstdio>
#include <cstdint>
#include <cmath>
namespace cg = cooperative_groups;
namespace pg8 {
#define PG8_LAS __attribute__((address_space(3)))
typedef unsigned short bf16_t;
typedef short bf16x8 __attribute__((ext_vector_type(8)));
typedef float f32x4 __attribute__((ext_vector_type(4)));
typedef unsigned u32x4 __attribute__((ext_vector_type(4)));
constexpr int BM = 256, BK = 64, HALF = 128, HTB = HALF * BK * 2  , STAGE_BYTES = 8 * HTB, NXCD = 8, WGM = 8;

__host__ __device__ __forceinline__ int lds_byte(int r, int c) { const int st = (r >> 4) * 2 + (c >> 5), rr = r & 15, cc = c & 31, ob = rr * 64 + cc * 2; return st * 1024 + (ob ^ (((ob >> 9) & 1) << 5)); }
__host__ __device__ __forceinline__ void stage_rc(int b, int& R, int& C) { const int st = b / 1024, sb = b % 1024, swz = sb ^ (((sb >> 9) & 1) << 5); R = (st >> 1) * 16 + swz / 64; C = (st & 1) * 32 + (swz % 64) / 2; }
__host__ __device__ __forceinline__ int perm32(int rho) { const int n = rho >> 4, i = rho & 15; return 8 * (i >> 2) + 4 * n + (i & 3); }

struct Unit { int pm, pn; };
struct Gemm { const bf16_t* A; const bf16_t* Bt; int M, N, K; };

struct StaticOrder {
    int nM, nN, nwg, G, c;
    __host__ __device__ void init(int M, int N, int G_, int c_) { nM = M / BM; nN = N / BM; nwg = nM * nN; G = G_; c = c_; }
    __host__ __device__ bool next(int i, Unit& u) const {
        const long L = (long)i * G + c; if (L >= nwg) return false;
        int wgid = (int)L; { const int q = nwg / NXCD, r = nwg % NXCD, xcd = wgid % NXCD, off = wgid / NXCD; wgid = (xcd < r ? xcd * (q + 1) : r * (q + 1) + (xcd - r) * q) + off; }
        const int nig = WGM * nN, gid = wgid / nig, fm = gid * WGM, gsz = (nM - fm) < WGM ? (nM - fm) : WGM;
        u.pm = fm + ((wgid % nig) % gsz); u.pn = (wgid % nig) / gsz; return true;
    }
    __device__ __forceinline__ void a_ready(const Unit&) const {}
    __device__ __forceinline__ void done(const Unit&) const {}
};

__device__ __forceinline__ unsigned cvt_pk_bf16(float lo, float hi) { unsigned r; asm volatile("v_cvt_pk_bf16_f32 %0, %1, %2" : "=v"(r) : "v"(lo), "v"(hi)); return r; }
typedef float f32x2 __attribute__((ext_vector_type(2)));
__device__ __forceinline__ float rstd_row(const float* ss, int row) {
    const f32x4* p = (const f32x4*)(ss + (size_t)row * 16);
    const f32x4 a = p[0], b = p[1], c = p[2], d = p[3];
    const f32x4 s = (a + b) + (c + d);
    const float t = (s[0] + s[1]) + (s[2] + s[3]);
    return __builtin_amdgcn_rsqf(t * (1.0f / 1024.0f) + 1e-5f);
}
constexpr int EPI_PANEL_OFF = 131072;
__device__ __forceinline__ void panel_fetch(const float* ss, PG8_LAS unsigned char* lds0, const Unit& u, int wid, int lane) {
    const float* src = ss + (size_t)u.pm * BM * 16 + (size_t)wid * 512 + lane * 4;
#pragma unroll
    for (int p = 0; p < 2; ++p)
        __builtin_amdgcn_global_load_lds((const unsigned*)(src + p * 256), (PG8_LAS unsigned*)(lds0 + EPI_PANEL_OFF + (wid * 2 + p) * 1024), 16, 0, 0);
}
__device__ __forceinline__ float rstd_panel(const PG8_LAS unsigned char* lds0, int rl) {
    const PG8_LAS f32x4* p = (const PG8_LAS f32x4*)(lds0 + EPI_PANEL_OFF + rl * 64);
    const f32x4 a = p[0], b = p[1], c = p[2], d = p[3];
    const f32x4 s = (a + b) + (c + d);
    const float t = (s[0] + s[1]) + (s[2] + s[3]);
    return __builtin_amdgcn_rsqf(t * (1.0f / 1024.0f) + 1e-5f);
}
constexpr int EPI_RSTD_OFF = 131072 + 16384;
__device__ __forceinline__ void rstd_table(PG8_LAS unsigned char* lds0, int wr, int wc, int fr, int fq) {
    const int tid = (wr * 4 + wc) * 64 + fq * 16 + fr;
    if (tid < 256) ((PG8_LAS float*)(lds0 + EPI_RSTD_OFF))[tid] = rstd_panel(lds0, tid);
    asm volatile("s_waitcnt lgkmcnt(0)" ::: "memory"); __builtin_amdgcn_s_barrier(); asm volatile("" ::: "memory");
}
struct EpiSwiGLU {
    static constexpr bool PERM = true, AFTER_DRAIN = false, HAS_PRE = true;
    bf16_t* H; const float* ss; PG8_LAS unsigned char* lds0;
    __device__ __forceinline__ void pre(const Unit& u, int wid, int lane) const { panel_fetch(ss, lds0, u, wid, lane); }
    __device__ __forceinline__ void operator()(const f32x4 (&acc)[2][2][4][2], const Unit& u, int wr, int wc, int fr, int fq) const {
        const int row0 = u.pm * BM + wr * 64 + fr; const int col = u.pn * 128 + wc * 32 + 8 * fq;
        const __amdgpu_buffer_rsrc_t hrs = __builtin_amdgcn_make_buffer_rsrc((void*)H, 0, 0x7fffffff, 0x00020000);
        rstd_table(lds0, wr, wc, fr, fq);
        const PG8_LAS float* RS = (const PG8_LAS float*)(lds0 + EPI_RSTD_OFF);
#pragma unroll
        for (int ai = 0; ai < 2; ++ai)
#pragma unroll
            for (int m = 0; m < 4; ++m) {
                const int row = row0 + ai * HALF + m * 16; const float rs = RS[wr * 64 + fr + ai * HALF + m * 16];
                f32x4 hv[2];
#pragma unroll
                for (int n = 0; n < 2; ++n) {
                    const f32x4 g4 = acc[ai][0][m][n] * rs, u4 = acc[ai][1][m][n] * rs, t4 = g4 * -1.4426950408889634f;
                    f32x4 e4; e4[0] = __builtin_amdgcn_exp2f(t4[0]); e4[1] = __builtin_amdgcn_exp2f(t4[1]); e4[2] = __builtin_amdgcn_exp2f(t4[2]); e4[3] = __builtin_amdgcn_exp2f(t4[3]);
                    const f32x4 d4 = e4 + 1.0f;
                    f32x4 r4; r4[0] = __builtin_amdgcn_rcpf(d4[0]); r4[1] = __builtin_amdgcn_rcpf(d4[1]); r4[2] = __builtin_amdgcn_rcpf(d4[2]); r4[3] = __builtin_amdgcn_rcpf(d4[3]);
                    hv[n] = (g4 * r4) * u4;
                }
                u32x4 w; w.x = cvt_pk_bf16(hv[0][0], hv[0][1]); w.y = cvt_pk_bf16(hv[0][2], hv[0][3]); w.z = cvt_pk_bf16(hv[1][0], hv[1][1]); w.w = cvt_pk_bf16(hv[1][2], hv[1][3]);
                __builtin_amdgcn_raw_buffer_store_b128(w, hrs, (unsigned)((row * 2816 + col) * 2), 0, 16);
            }
    }
};
struct EpiRes {
    static constexpr bool PERM = true, AFTER_DRAIN = false, HAS_PRE = false;
    bf16_t* xb; float* ss; float alpha;
    __device__ __forceinline__ void operator()(const f32x4 (&acc)[2][2][4][2], const Unit& u, int wr, int wc, int fr, int fq) const {
        const int row0 = u.pm * BM + wr * 64 + fr;
        u32x4 rv[2][4][2];
#pragma unroll
        for (int ai = 0; ai < 2; ++ai)
#pragma unroll
            for (int m = 0; m < 4; ++m)
#pragma unroll
                for (int bj = 0; bj < 2; ++bj) rv[ai][m][bj] = *(const u32x4*)(xb + (size_t)(row0 + ai * HALF + m * 16) * 1024 + u.pn * BM + bj * HALF + wc * 32 + 8 * fq);
#pragma unroll
        for (int ai = 0; ai < 2; ++ai)
#pragma unroll
            for (int m = 0; m < 4; ++m) {
                const int row = row0 + ai * HALF + m * 16; float sq = 0.f;
#pragma unroll
                for (int bj = 0; bj < 2; ++bj) {
                    const size_t off = (size_t)row * 1024 + u.pn * BM + bj * HALF + wc * 32 + 8 * fq;
                    const u32x4 r = rv[ai][m][bj];
                    const f32x4 a0 = {__uint_as_float(r.x << 16), __uint_as_float(r.x & 0xffff0000u), __uint_as_float(r.y << 16), __uint_as_float(r.y & 0xffff0000u)};
                    const f32x4 a1 = {__uint_as_float(r.z << 16), __uint_as_float(r.z & 0xffff0000u), __uint_as_float(r.w << 16), __uint_as_float(r.w & 0xffff0000u)};
                    const f32x4 v0 = a0 + acc[ai][bj][m][0] * alpha, v1 = a1 + acc[ai][bj][m][1] * alpha;
                    u32x4 w; w.x = cvt_pk_bf16(v0[0], v0[1]); w.y = cvt_pk_bf16(v0[2], v0[3]); w.z = cvt_pk_bf16(v1[0], v1[1]); w.w = cvt_pk_bf16(v1[2], v1[3]);
                    *(u32x4*)(xb + off) = w;
                    sq += (v0[0] * v0[0] + v0[1] * v0[1]) + (v0[2] * v0[2] + v0[3] * v0[3]) + (v1[0] * v1[0] + v1[1] * v1[1]) + (v1[2] * v1[2] + v1[3] * v1[3]);
                }
                sq += __shfl_xor(sq, 16); sq += __shfl_xor(sq, 32);
                if (fq == 0) ss[(size_t)row * 16 + u.pn * 4 + wc] = sq;
            }
    }
};
struct EpiFinal {
    static constexpr bool PERM = true, AFTER_DRAIN = false, HAS_PRE = false;
    const bf16_t* xb; float* out; const float* gain; unsigned* slots; unsigned* cnt; PG8_LAS unsigned char* elds; float alpha;
    __device__ __forceinline__ void operator()(f32x4 (&acc)[2][2][4][2], const Unit& u, int wr, int wc, int fr, int fq) const {
        PG8_LAS float* P = (PG8_LAS float*)elds;
        PG8_LAS float* S = P + 1024;
        const int wid = wr * 4 + wc, lane = fq * 16 + fr, tid = wid * 64 + lane;
        const int row0 = u.pm * BM + wr * 64 + fr;
        u32x4 rv[2][4][2];
#pragma unroll
        for (int ai = 0; ai < 2; ++ai)
#pragma unroll
            for (int m = 0; m < 4; ++m)
#pragma unroll
                for (int bj = 0; bj < 2; ++bj) rv[ai][m][bj] = *(const u32x4*)(xb + (size_t)(row0 + ai * HALF + m * 16) * 1024 + u.pn * BM + bj * HALF + wc * 32 + 8 * fq);
#pragma unroll
        for (int ai = 0; ai < 2; ++ai)
#pragma unroll
            for (int m = 0; m < 4; ++m) {
                float sq = 0.f;
#pragma unroll
                for (int bj = 0; bj < 2; ++bj) {
                    const u32x4 r = rv[ai][m][bj];
                    const f32x4 a0 = {__uint_as_float(r.x << 16), __uint_as_float(r.x & 0xffff0000u), __uint_as_float(r.y << 16), __uint_as_float(r.y & 0xffff0000u)};
                    const f32x4 a1 = {__uint_as_float(r.z << 16), __uint_as_float(r.z & 0xffff0000u), __uint_as_float(r.w << 16), __uint_as_float(r.w & 0xffff0000u)};
                    const f32x4 v0 = a0 + acc[ai][bj][m][0] * alpha, v1 = a1 + acc[ai][bj][m][1] * alpha;
                    acc[ai][bj][m][0] = v0; acc[ai][bj][m][1] = v1;
                    sq += (v0[0] * v0[0] + v0[1] * v0[1]) + (v0[2] * v0[2] + v0[3] * v0[3]) + (v1[0] * v1[0] + v1[1] * v1[1]) + (v1[2] * v1[2] + v1[3] * v1[3]);
                }
                sq += __shfl_xor(sq, 16); sq += __shfl_xor(sq, 32);
                if (fq == 0) P[(ai * HALF + wr * 64 + m * 16 + fr) * 4 + wc] = sq;
            }
        asm volatile("s_waitcnt lgkmcnt(0)" ::: "memory"); __builtin_amdgcn_s_barrier(); asm volatile("" ::: "memory");
        if (tid < 256) { const f32x4 p = *(const PG8_LAS f32x4*)(P + tid * 4); const float sr = (p[0] + p[1]) + (p[2] + p[3]);
            __hip_atomic_store(slots + (size_t)(u.pm * BM + tid) * 16 + u.pn, __float_as_uint(sr), __ATOMIC_RELAXED, __HIP_MEMORY_SCOPE_AGENT); }
        asm volatile("s_waitcnt vmcnt(0)" ::: "memory");
        if (tid < 256 && lane == 0) __hip_atomic_fetch_add(cnt + 64 * u.pm, 1u, __ATOMIC_RELAXED, __HIP_MEMORY_SCOPE_AGENT);
        if (wid == 0) {
            unsigned sp = 0;
            while ((unsigned)__builtin_amdgcn_readfirstlane(__hip_atomic_load(cnt + 64 * u.pm, __ATOMIC_RELAXED, __HIP_MEMORY_SCOPE_AGENT)) < 16u) { __builtin_amdgcn_s_sleep(1); if (++sp > (1u << 20)) break; }
            __builtin_amdgcn_fence(__ATOMIC_ACQUIRE, "agent");
        }
        asm volatile("s_waitcnt vmcnt(0) lgkmcnt(0)" ::: "memory"); __builtin_amdgcn_s_barrier(); asm volatile("" ::: "memory");
        if (tid < 256) { const unsigned* sl = slots + (size_t)(u.pm * BM + tid) * 16; float t = 0.f;
#pragma unroll
            for (int k = 0; k < 4; ++k) t += __uint_as_float(__hip_atomic_load(sl + k, __ATOMIC_RELAXED, __HIP_MEMORY_SCOPE_AGENT));
            S[tid] = __builtin_amdgcn_rsqf(t * (1.0f / 1024.0f) + 1e-5f); }
        asm volatile("s_waitcnt lgkmcnt(0)" ::: "memory"); __builtin_amdgcn_s_barrier(); asm volatile("" ::: "memory");
        f32x4 gv[2][2];
#pragma unroll
        for (int bj = 0; bj < 2; ++bj) { const float* gp = gain + u.pn * BM + bj * HALF + wc * 32 + 8 * fq; gv[bj][0] = *(const f32x4*)gp; gv[bj][1] = *(const f32x4*)(gp + 4); }
#pragma unroll
        for (int ai = 0; ai < 2; ++ai)
#pragma unroll
            for (int m = 0; m < 4; ++m) {
                const int rl = ai * HALF + wr * 64 + m * 16 + fr; const float rs = S[rl];
#pragma unroll
                for (int bj = 0; bj < 2; ++bj) { float* op = out + (size_t)(u.pm * BM + rl) * 1024 + u.pn * BM + bj * HALF + wc * 32 + 8 * fq;
                    *(f32x4*)op = acc[ai][bj][m][0] * rs * gv[bj][0]; *(f32x4*)(op + 4) = acc[ai][bj][m][1] * rs * gv[bj][1]; }
            }
        asm volatile("s_waitcnt lgkmcnt(0)" ::: "memory"); __builtin_amdgcn_s_barrier(); asm volatile("" ::: "memory");
    }
};
struct EpiProj {
    static constexpr bool PERM = true, AFTER_DRAIN = false, HAS_PRE = true;
    bf16_t* P; const float* ss; const float* cs; float qscale; PG8_LAS unsigned char* lds0;
    __device__ __forceinline__ void pre(const Unit& u, int wid, int lane) const { panel_fetch(ss, lds0, u, wid, lane); }
    __device__ __forceinline__ void operator()(const f32x4 (&acc)[2][2][4][2], const Unit& u, int wr, int wc, int fr, int fq) const {
        const int pn = u.pn; const bool rope = !(pn == 4 || pn == 5 || pn >= 10) && ((wc & 1) == 0);
        const float qs = (pn < 2 || pn == 6 || pn == 7) ? qscale : 1.0f;
        const int row0 = u.pm * BM + wr * 64 + fr;
        rstd_table(lds0, wr, wc, fr, fq);
        const PG8_LAS float* RS = (const PG8_LAS float*)(lds0 + EPI_RSTD_OFF);
#pragma unroll
        for (int ai = 0; ai < 2; ++ai)
#pragma unroll
            for (int m = 0; m < 4; ++m) {
                const int row = row0 + ai * HALF + m * 16; const float rs = RS[wr * 64 + fr + ai * HALF + m * 16];
                f32x4 c0 = {1.f, 1.f, 1.f, 1.f}, c1 = c0, s0 = {0.f, 0.f, 0.f, 0.f}, s1 = s0;
                if (rope && fq < 2) { const f32x4* t = (const f32x4*)(cs + (size_t)row * 16); c0 = t[0]; c1 = t[1]; s0 = t[2]; s1 = t[3]; if (fq == 0) { s0 = -s0; s1 = -s1; } }
#pragma unroll
                for (int bj = 0; bj < 2; ++bj) {
                    f32x4 v0 = acc[ai][bj][m][0] * rs, v1 = acc[ai][bj][m][1] * rs;
                    if (rope) { f32x4 p0, p1;
#pragma unroll
                        for (int j = 0; j < 4; ++j) { p0[j] = __shfl_xor(v0[j], 16); p1[j] = __shfl_xor(v1[j], 16); }
                        v0 = v0 * c0 + p0 * s0; v1 = v1 * c1 + p1 * s1; }
                    v0 = v0 * qs; v1 = v1 * qs;
                    u32x4 w; w.x = cvt_pk_bf16(v0[0], v0[1]); w.y = cvt_pk_bf16(v0[2], v0[3]); w.z = cvt_pk_bf16(v1[0], v1[1]); w.w = cvt_pk_bf16(v1[2], v1[3]);
                    *(u32x4*)(P + (size_t)row * 3072 + pn * BM + bj * HALF + wc * 32 + 8 * fq) = w;
                }
            }
    }
};
template <class Epi, class Sched, bool ALIGN_EPI = false, bool SP2 = false>
__device__ __forceinline__ void gemm_phase(PG8_LAS unsigned char* lds, const Gemm g, const Sched& S, const Epi& E) {
    const int tid = threadIdx.x, wid = __builtin_amdgcn_readfirstlane(tid >> 6), lane = tid & 63, wr = wid >> 2, wc = wid & 3, fr = lane & 15, fq = lane >> 4;
    const int K = g.K, nt = K / BK;
    unsigned voffA[2], voffB[2];
#pragma unroll
    for (int i = 0; i < 2; ++i) { int R, C; stage_rc(tid * 16 + i * 8192, R, C); const int Rb = Epi::PERM ? ((R & ~31) + perm32(R & 31)) : R;
        voffA[i] = (unsigned)(R * K + C) * 2u; voffB[i] = (unsigned)(Rb * K + C) * 2u; }
    const size_t kstep = (size_t)(BK * 2);
    const size_t hstep = (size_t)HALF * K * 2;
    const size_t tstep = 2 * hstep;
    const unsigned ldsw = (unsigned)wid * 1024u;
    const int aoff = lds_byte(wr * 64 + fr, fq * 8), boff = lds_byte(wc * 32 + fr, fq * 8);
#define PG8_SA(b, h) (((b) * 2 + (h)) * HTB)
#define PG8_SB(b, h) ((4 + (b) * 2 + (h)) * HTB)
#define PG8_STAGE(bufoff, gbase, voff) do { _Pragma("unroll") for (int _i = 0; _i < 2; ++_i) \
        __builtin_amdgcn_global_load_lds((const unsigned*)((const char*)(gbase) + (voff)[_i]), (PG8_LAS unsigned*)(lds + (bufoff) + ldsw + _i * 8192), 16, 0, 0); } while (0)
#define PG8_LDA(dst, b, h) do { _Pragma("unroll") for (int m = 0; m < 4; ++m) _Pragma("unroll") for (int k = 0; k < 2; ++k) dst[m][k] = *(const PG8_LAS bf16x8*)(lds + PG8_SA(b, h) + aoff + m * 2048 + k * 1024); } while (0)
#define PG8_LDB(dst, b, h) do { _Pragma("unroll") for (int n = 0; n < 2; ++n) _Pragma("unroll") for (int k = 0; k < 2; ++k) dst[n][k] = *(const PG8_LAS bf16x8*)(lds + PG8_SB(b, h) + boff + n * 2048 + k * 1024); } while (0)
#define PG8_MMA(ai, bj, At, Bt) do { __builtin_amdgcn_s_setprio(1); _Pragma("unroll") for (int m = 0; m < 4; ++m) _Pragma("unroll") for (int n = 0; n < 2; ++n) _Pragma("unroll") for (int k = 0; k < 2; ++k) \
        acc[ai][bj][m][n] = __builtin_amdgcn_mfma_f32_16x16x32_bf16(Bt[n][k], At[m][k], acc[ai][bj][m][n], 0, 0, 0); __builtin_amdgcn_s_setprio(0); } while (0)
#define PG8_WAIT_V(n) asm volatile("s_waitcnt vmcnt(" #n ")" ::: "memory")
#define PG8_WAIT_L(n) asm volatile("s_waitcnt lgkmcnt(" #n ")" ::: "memory")
#define PG8_BAR __builtin_amdgcn_s_barrier()
#define PG8_SCHED __builtin_amdgcn_sched_barrier(0)
    Unit cur, nxt; int ui = 0;
    if (!S.next(0, cur)) return;
    if constexpr (Epi::HAS_PRE) E.pre(cur, wid, lane);
    f32x4 acc[2][2][4][2];
#pragma unroll
    for (int a = 0; a < 2; ++a)
#pragma unroll
        for (int b = 0; b < 2; ++b)
#pragma unroll
            for (int m = 0; m < 4; ++m)
#pragma unroll
                for (int n = 0; n < 2; ++n) acc[a][b][m][n] = (f32x4){0.f, 0.f, 0.f, 0.f};
    bf16x8 At[4][2], B0[2][2], B1[2][2];
    const char* cA = (const char*)g.A + (size_t)cur.pm * tstep; const char* cB = (const char*)g.Bt + (size_t)cur.pn * tstep;
    S.a_ready(cur);
    if constexpr (SP2) {
        PG8_STAGE(PG8_SB(0, 0), cB, voffB); PG8_STAGE(PG8_SB(0, 1), cB + hstep, voffB); PG8_STAGE(PG8_SA(0, 0), cA, voffA); PG8_STAGE(PG8_SA(0, 1), cA + hstep, voffA);
        if (wr == 1) PG8_BAR;
        PG8_WAIT_V(2); PG8_BAR;
        PG8_STAGE(PG8_SB(1, 0), cB + kstep, voffB); PG8_STAGE(PG8_SA(1, 0), cA + kstep, voffA); PG8_STAGE(PG8_SB(1, 1), cB + hstep + kstep, voffB);
        PG8_WAIT_V(6); PG8_BAR;
    } else {
        PG8_STAGE(PG8_SB(0, 0), cB, voffB); PG8_STAGE(PG8_SA(0, 0), cA, voffA); PG8_STAGE(PG8_SB(0, 1), cB + hstep, voffB); PG8_STAGE(PG8_SA(0, 1), cA + hstep, voffA);
        if (wr == 1) PG8_BAR;
        PG8_WAIT_V(4); PG8_BAR;
        PG8_STAGE(PG8_SB(1, 0), cB + kstep, voffB); PG8_STAGE(PG8_SA(1, 0), cA + kstep, voffA); PG8_STAGE(PG8_SB(1, 1), cB + hstep + kstep, voffB);
        PG8_WAIT_V(6); PG8_BAR;
    }
    for (;;) {
        const bool has_next = S.next(ui + 1, nxt);
        const char* nA = has_next ? (const char*)g.A + (size_t)nxt.pm * tstep : cA; const char* nB = has_next ? (const char*)g.Bt + (size_t)nxt.pn * tstep : cB;
        for (int t = 0; t < nt; t += 2) {
            const bool last = (t == nt - 2);
            const char* a1 = cA + (size_t)(t + 1) * kstep;
            const char* a2 = last ? nA : cA + (size_t)(t + 2) * kstep; const char* b2 = last ? nB : cB + (size_t)(t + 2) * kstep;
            const char* a3 = a2 + kstep; const char* b3 = b2 + kstep;
            if (last && has_next) S.a_ready(nxt);
            if constexpr (SP2) {
            PG8_LDB(B0, 0, 0); PG8_LDB(B1, 0, 1); PG8_SCHED; PG8_LDA(At, 0, 0); PG8_STAGE(PG8_SA(1, 1), a1 + hstep, voffA);
            PG8_WAIT_V(8); PG8_WAIT_L(0); PG8_BAR; PG8_MMA(0, 0, At, B0); PG8_MMA(0, 1, At, B1); PG8_BAR; PG8_SCHED;
            PG8_LDA(At, 0, 1); PG8_STAGE(PG8_SB(0, 0), b2, voffB); PG8_STAGE(PG8_SB(0, 1), b2 + hstep, voffB); PG8_STAGE(PG8_SA(0, 0), a2, voffA);
            PG8_WAIT_V(8); PG8_WAIT_L(0); PG8_BAR; PG8_MMA(1, 0, At, B0); PG8_MMA(1, 1, At, B1); PG8_BAR; PG8_SCHED;
            PG8_LDB(B0, 1, 0); PG8_LDB(B1, 1, 1); PG8_SCHED; PG8_LDA(At, 1, 0); PG8_STAGE(PG8_SA(0, 1), a2 + hstep, voffA);
            PG8_WAIT_V(8); PG8_WAIT_L(0); PG8_BAR; PG8_MMA(0, 0, At, B0); PG8_MMA(0, 1, At, B1); PG8_BAR; PG8_SCHED;
            PG8_LDA(At, 1, 1); PG8_STAGE(PG8_SB(1, 0), b3, voffB); PG8_STAGE(PG8_SB(1, 1), b3 + hstep, voffB); PG8_STAGE(PG8_SA(1, 0), a3, voffA);
            PG8_WAIT_V(8); PG8_WAIT_L(0); PG8_BAR; PG8_MMA(1, 0, At, B0); PG8_MMA(1, 1, At, B1); PG8_BAR; PG8_SCHED;
            } else {
            PG8_LDB(B0, 0, 0); PG8_SCHED; PG8_LDA(At, 0, 0); PG8_STAGE(PG8_SA(1, 1), a1 + hstep, voffA);
            PG8_WAIT_L(8); PG8_BAR; PG8_WAIT_L(0); PG8_MMA(0, 0, At, B0); PG8_BAR; PG8_SCHED;
            PG8_LDB(B1, 0, 1); PG8_STAGE(PG8_SB(0, 0), b2, voffB);
            PG8_BAR; PG8_WAIT_L(0); PG8_MMA(0, 1, At, B1); PG8_BAR;
            PG8_LDA(At, 0, 1); PG8_STAGE(PG8_SA(0, 0), a2, voffA);
            PG8_BAR; PG8_WAIT_L(0); PG8_MMA(1, 0, At, B0); PG8_BAR; PG8_SCHED;
            PG8_STAGE(PG8_SB(0, 1), b2 + hstep, voffB);
            PG8_WAIT_V(6); PG8_BAR; PG8_MMA(1, 1, At, B1); PG8_BAR;
            PG8_LDB(B0, 1, 0); PG8_SCHED; PG8_LDA(At, 1, 0); PG8_STAGE(PG8_SA(0, 1), a2 + hstep, voffA);
            PG8_WAIT_L(8); PG8_BAR; PG8_WAIT_L(0); PG8_MMA(0, 0, At, B0); PG8_BAR; PG8_SCHED;
            PG8_LDB(B1, 1, 1); PG8_STAGE(PG8_SB(1, 0), b3, voffB);
            PG8_BAR; PG8_WAIT_L(0); PG8_MMA(0, 1, At, B1); PG8_BAR;
            PG8_LDA(At, 1, 1); PG8_STAGE(PG8_SA(1, 0), a3, voffA);
            PG8_BAR; PG8_WAIT_L(0); PG8_MMA(1, 0, At, B0); PG8_BAR; PG8_SCHED;
            PG8_STAGE(PG8_SB(1, 1), b3 + hstep, voffB);
            PG8_WAIT_V(6); PG8_BAR; PG8_MMA(1, 1, At, B1); PG8_BAR;
            }
        }
        if constexpr (ALIGN_EPI) { if (wr == 0) PG8_BAR; }
        if constexpr (!Epi::AFTER_DRAIN) { E(acc, cur, wr, wc, fr, fq); S.done(cur); }
        if (!has_next) break;
        if constexpr (Epi::HAS_PRE) { asm volatile("s_waitcnt lgkmcnt(0)" ::: "memory"); PG8_BAR; E.pre(nxt, wid, lane); }
#pragma unroll
        for (int a = 0; a < 2; ++a)
#pragma unroll
            for (int b = 0; b < 2; ++b)
#pragma unroll
                for (int m = 0; m < 4; ++m)
#pragma unroll
                    for (int n = 0; n < 2; ++n) acc[a][b][m][n] = (f32x4){0.f, 0.f, 0.f, 0.f};
        cur = nxt; cA = nA; cB = nB; ++ui;
        if constexpr (ALIGN_EPI) { if (wr == 1) PG8_BAR; }
    }
    PG8_WAIT_V(0);
    if constexpr (!ALIGN_EPI) { if (wr == 0) PG8_BAR; }
    PG8_BAR;
    if constexpr (Epi::AFTER_DRAIN) { E.fused(acc, cur, wr, wc, fr, fq, lds, wid, lane); S.done(cur); }
#undef PG8_SA
#undef PG8_SB
#undef PG8_STAGE
#undef PG8_LDA
#undef PG8_LDB
#undef PG8_MMA
#undef PG8_WAIT_V
#undef PG8_WAIT_L
#undef PG8_BAR
#undef PG8_SCHED
}
}

constexpr int DM = 1024, BATCH = 16, SEQ = 2048, M = BATCH * SEQ, DFF = 2816, INC = 3072;
constexpr float C2 = 0.125f * 1.4426950408889634f;
constexpr float NEGB = -1.0e30f;

#define GAS __attribute__((address_space(1)))
#define LAS __attribute__((address_space(3)))
typedef unsigned short bf16;
typedef unsigned v4u __attribute__((ext_vector_type(4)));
typedef float f32x4 __attribute__((ext_vector_type(4)));
typedef float f32x16 __attribute__((ext_vector_type(16)));
typedef short bf16x8 __attribute__((ext_vector_type(8)));
typedef short s16x4 __attribute__((ext_vector_type(4)));
typedef LAS const char* lds_cptr;

constexpr size_t MiB = 1u << 20;
constexpr size_t WS_SS = 0, WS_CS = 2 * MiB, WS_WGU1 = 4 * MiB, WS_WD1 = 15 * MiB, WS_WIN = 21 * MiB, WS_WOUT = 27 * MiB, WS_WGU2 = 29 * MiB, WS_WD2 = 40 * MiB;
constexpr size_t WS_XB = 48 * MiB, WS_MIX = 112 * MiB, WS_HP = 176 * MiB, WS_END = 368 * MiB;
constexpr size_t WS_BAR = 47 * MiB, BAR_BYTES = 65536;
constexpr int LDS_BYTES = 151552, LDS_MISC = 151552 - 64;

__device__ __forceinline__ unsigned f2bf(float f) { unsigned u = __builtin_bit_cast(unsigned, f); return (u + 0x7fffu + ((u >> 16) & 1u)) >> 16; }
__device__ __forceinline__ unsigned pk2(float lo, float hi) { unsigned r; asm volatile("v_cvt_pk_bf16_f32 %0, %1, %2" : "=v"(r) : "v"(lo), "v"(hi)); return r; }
__device__ __forceinline__ unsigned cvtpk(float lo, float hi) { unsigned r; asm volatile("v_cvt_pk_bf16_f32 %0, %1, %2" : "=v"(r) : "v"(lo), "v"(hi)); return r; }
__device__ __forceinline__ float wave_sum(float v) {
#pragma unroll
    for (int o = 1; o < 64; o <<= 1) v += __shfl_xor(v, o);
    return v;
}
#define LDS_WAIT() asm volatile("s_waitcnt lgkmcnt(0)" ::: "memory")

__device__ __forceinline__ int crow(int r, int hi) { return (r & 3) + 8 * (r >> 2) + 4 * hi; }
typedef short v4i16_t __attribute__((ext_vector_type(4)));
__device__ __forceinline__ s16x4 vtr(lds_cptr p) { return __builtin_bit_cast(s16x4, __builtin_amdgcn_ds_read_tr16_b64_v4i16((LAS v4i16_t*)p)); }
__device__ __forceinline__ float swap_add(float v) { auto rr = __builtin_amdgcn_permlane32_swap(__float_as_uint(v), __float_as_uint(v), false, false); return __uint_as_float(rr[0]) + __uint_as_float(rr[1]); }
__device__ __forceinline__ float swap_max(float v) { auto rr = __builtin_amdgcn_permlane32_swap(__float_as_uint(v), __float_as_uint(v), false, false); return fmaxf(__uint_as_float(rr[0]), __uint_as_float(rr[1])); }

__device__ __forceinline__ void attn_qk(f32x16& p0, f32x16& p1, const bf16x8 (&kf)[8], const bf16x8 (&qr)[4]) {
    p0 = f32x16{}; p1 = f32x16{};
#pragma unroll
    for (int d0 = 0; d0 < 4; ++d0) {
        p0 = __builtin_amdgcn_mfma_f32_32x32x16_bf16(kf[2 * d0], qr[d0], p0, 0, 0, 0);
        p1 = __builtin_amdgcn_mfma_f32_32x32x16_bf16(kf[2 * d0 + 1], qr[d0], p1, 0, 0, 0);
    }
}
template <int NDV, bool EARLY = true>
__device__ __forceinline__ void attn_sv(f32x16 (&o)[NDV], float& mrow, float& lrow, f32x16& p0, f32x16& p1, lds_cptr vlane, LAS float* wsf,
                                        int qidx, int kbase, int win, bool need_mask, int hi, int r32) {
    s16x4 vf[2][8];
    if (EARLY) {
#pragma unroll
        for (int ks = 0; ks < 4; ++ks) { vf[0][2 * ks] = vtr(vlane + ks * 1024); vf[0][2 * ks + 1] = vtr(vlane + ks * 1024 + 512); }
        __builtin_amdgcn_sched_barrier(0);
    }
    if (need_mask) {
        int e = qidx - kbase - 4 * hi; asm volatile("" : "+v"(e));
        const int el = e - win;
#pragma unroll
        for (int r = 0; r < 16; ++r) { const int cr = (r & 3) + 8 * (r >> 2);
            p0[r] = (cr <= e && cr >= el) ? p0[r] : NEGB; p1[r] = (cr + 32 <= e && cr + 32 >= el) ? p1[r] : NEGB; }
    }
    float rm;
    { float a = __builtin_fmaxf(__builtin_fmaxf(p0[0], p0[1]), p1[0]), b = __builtin_fmaxf(__builtin_fmaxf(p0[2], p0[3]), p1[1]); a = __builtin_fmaxf(__builtin_fmaxf(a, p1[2]), p1[3]);
#pragma unroll
      for (int r = 4; r < 16; r += 4) { a = __builtin_fmaxf(__builtin_fmaxf(a, p0[r]), p0[r + 1]); b = __builtin_fmaxf(__builtin_fmaxf(b, p0[r + 2]), p0[r + 3]);
          a = __builtin_fmaxf(__builtin_fmaxf(a, p1[r]), p1[r + 1]); b = __builtin_fmaxf(__builtin_fmaxf(b, p1[r + 2]), p1[r + 3]); }
      rm = __builtin_fmaxf(a, b); }
    rm = swap_max(rm);
    const float mn = (rm - mrow > 8.0f) ? rm : mrow, f = __builtin_amdgcn_exp2f(mrow - mn); mrow = mn;
    typedef float f32x2_t __attribute__((ext_vector_type(2)));
    f32x2_t s2 = {0.f, 0.f};
#pragma unroll
    for (int r = 0; r < 16; r += 2) { p0[r] = __builtin_amdgcn_exp2f(p0[r] - mn); p0[r + 1] = __builtin_amdgcn_exp2f(p0[r + 1] - mn); p1[r] = __builtin_amdgcn_exp2f(p1[r] - mn); p1[r + 1] = __builtin_amdgcn_exp2f(p1[r + 1] - mn);
        s2 += (f32x2_t){p0[r], p0[r + 1]}; s2 += (f32x2_t){p1[r], p1[r + 1]}; }
    lrow = lrow * f + (s2.x + s2.y);
    if (__any(f != 1.0f)) {
        if (hi == 0) wsf[r32] = f;
        LAS float* wq = wsf + 4 * hi; asm volatile("" : "+v"(wq));
#pragma unroll
        for (int r = 0; r < 16; ++r) { const float fr_ = wq[(r & 3) + 8 * (r >> 2)];
#pragma unroll
            for (int d = 0; d < NDV; ++d) o[d][r] *= fr_; }
    }
    v4u pw[4];
#pragma unroll
    for (int k = 0; k < 2; ++k) {
        pw[k]     = (v4u){cvtpk(p0[8 * k], p0[8 * k + 1]), cvtpk(p0[8 * k + 2], p0[8 * k + 3]), cvtpk(p0[8 * k + 4], p0[8 * k + 5]), cvtpk(p0[8 * k + 6], p0[8 * k + 7])};
        pw[2 + k] = (v4u){cvtpk(p1[8 * k], p1[8 * k + 1]), cvtpk(p1[8 * k + 2], p1[8 * k + 3]), cvtpk(p1[8 * k + 4], p1[8 * k + 5]), cvtpk(p1[8 * k + 6], p1[8 * k + 7])};
    }
    __builtin_amdgcn_sched_barrier(0);
#pragma unroll
    for (int d0 = 0; d0 < NDV; ++d0) {
        if (EARLY) {
            if (d0 + 1 < NDV) {
#pragma unroll
                for (int ks = 0; ks < 4; ++ks) { vf[(d0 + 1) & 1][2 * ks] = vtr(vlane + (d0 + 1) * 4096 + ks * 1024); vf[(d0 + 1) & 1][2 * ks + 1] = vtr(vlane + (d0 + 1) * 4096 + ks * 1024 + 512); }
            }
        } else {
#pragma unroll
            for (int ks = 0; ks < 4; ++ks) { vf[d0 & 1][2 * ks] = vtr(vlane + d0 * 4096 + ks * 1024); vf[d0 & 1][2 * ks + 1] = vtr(vlane + d0 * 4096 + ks * 1024 + 512); }
        }
        __builtin_amdgcn_sched_barrier(0);
#pragma unroll
        for (int ks = 0; ks < 4; ++ks) {
            const s16x4 lo = vf[d0 & 1][2 * ks], hv = vf[d0 & 1][2 * ks + 1];
            const bf16x8 vfr = (bf16x8){lo[0], lo[1], lo[2], lo[3], hv[0], hv[1], hv[2], hv[3]};
            o[d0] = __builtin_amdgcn_mfma_f32_32x32x16_bf16(__builtin_bit_cast(bf16x8, pw[ks]), vfr, o[d0], 0, 0, 0);
        }
        __builtin_amdgcn_sched_barrier(0);
    }
}
template <int NDV>
__device__ __forceinline__ void attn_tile(f32x16 (&o)[NDV], float& mrow, float& lrow, const bf16x8 (&kf)[8], const bf16x8 (&qr)[4], lds_cptr vlane, LAS float* wsf,
                                          int qidx, int kbase, int win, bool need_mask, int hi, int r32) {
    f32x16 p0, p1;
    attn_qk(p0, p1, kf, qr);
    attn_sv<NDV>(o, mrow, lrow, p0, p1, vlane, wsf, qidx, kbase, win, need_mask, hi, r32);
}

__device__ __forceinline__ void attn_qk_h(f32x16& p0, f32x16& p1, const bf16x8 (&kf)[8], const bf16x8 (&qr)[4], int hm) {
    if (hm & 1) { p0 = f32x16{};
#pragma unroll
        for (int d0 = 0; d0 < 4; ++d0) p0 = __builtin_amdgcn_mfma_f32_32x32x16_bf16(kf[2 * d0], qr[d0], p0, 0, 0, 0); }
    if (hm & 2) { p1 = f32x16{};
#pragma unroll
        for (int d0 = 0; d0 < 4; ++d0) p1 = __builtin_amdgcn_mfma_f32_32x32x16_bf16(kf[2 * d0 + 1], qr[d0], p1, 0, 0, 0); }
}
__device__ __forceinline__ float max16(const f32x16& p) {
    float a = __builtin_fmaxf(__builtin_fmaxf(p[0], p[1]), p[2]), b = __builtin_fmaxf(__builtin_fmaxf(p[3], p[4]), p[5]);
    a = __builtin_fmaxf(__builtin_fmaxf(a, p[6]), p[7]); b = __builtin_fmaxf(__builtin_fmaxf(b, p[8]), p[9]);
    a = __builtin_fmaxf(__builtin_fmaxf(a, p[10]), p[11]); b = __builtin_fmaxf(__builtin_fmaxf(b, p[12]), p[13]);
    return __builtin_fmaxf(__builtin_fmaxf(a, p[14]), __builtin_fmaxf(b, p[15]));
}
template <int NDV>
__device__ __forceinline__ void attn_smx_h(f32x16 (&o)[NDV], float& mrow, float& lrow, f32x16& p0, f32x16& p1, v4u (&pw)[4], LAS float* wsf,
                                           int qidx, int kbase, int win, int hm, int mm, int hi, int r32) {
    int e = qidx - kbase - 4 * hi; asm volatile("" : "+v"(e));
    const int el = e - win;
    float rm = NEGB;
    if (hm & 1) {
        if (mm & 1) {
#pragma unroll
            for (int r = 0; r < 16; ++r) { const int cr = (r & 3) + 8 * (r >> 2); p0[r] = (cr <= e && cr >= el) ? p0[r] : NEGB; } }
        rm = max16(p0);
    }
    if (hm & 2) {
        if (mm & 2) {
#pragma unroll
            for (int r = 0; r < 16; ++r) { const int cr = (r & 3) + 8 * (r >> 2) + 32; p1[r] = (cr <= e && cr >= el) ? p1[r] : NEGB; } }
        rm = __builtin_fmaxf(rm, max16(p1));
    }
    rm = swap_max(rm);
    const float mn = (rm - mrow > 8.0f) ? rm : mrow, f = __builtin_amdgcn_exp2f(mrow - mn); mrow = mn;
    float s = 0.f;
    if (hm & 1) {
#pragma unroll
        for (int r = 0; r < 16; ++r) { p0[r] = __builtin_amdgcn_exp2f(p0[r] - mn); s += p0[r]; }
#pragma unroll
        for (int k = 0; k < 2; ++k) pw[k] = (v4u){cvtpk(p0[8 * k], p0[8 * k + 1]), cvtpk(p0[8 * k + 2], p0[8 * k + 3]), cvtpk(p0[8 * k + 4], p0[8 * k + 5]), cvtpk(p0[8 * k + 6], p0[8 * k + 7])};
    }
    if (hm & 2) {
#pragma unroll
        for (int r = 0; r < 16; ++r) { p1[r] = __builtin_amdgcn_exp2f(p1[r] - mn); s += p1[r]; }
#pragma unroll
        for (int k = 0; k < 2; ++k) pw[2 + k] = (v4u){cvtpk(p1[8 * k], p1[8 * k + 1]), cvtpk(p1[8 * k + 2], p1[8 * k + 3]), cvtpk(p1[8 * k + 4], p1[8 * k + 5]), cvtpk(p1[8 * k + 6], p1[8 * k + 7])};
    }
    lrow = lrow * f + s;
    if (__any(f != 1.0f)) {
        if (hi == 0) wsf[r32] = f;
        LAS float* wq = wsf + 4 * hi; asm volatile("" : "+v"(wq));
#pragma unroll
        for (int r = 0; r < 16; ++r) { const float fr_ = wq[(r & 3) + 8 * (r >> 2)];
#pragma unroll
            for (int d = 0; d < NDV; ++d) o[d][r] *= fr_; }
    }
}
template <int NDV>
__device__ __forceinline__ void attn_pv_h(f32x16 (&o)[NDV], const v4u (&pw)[4], lds_cptr vlane, int hm) {
#pragma unroll
    for (int h = 0; h < 2; ++h) {
        if ((hm >> h) & 1) {
            s16x4 vf[2][2 * NDV];
#pragma unroll
            for (int k2 = 0; k2 < 2; ++k2)
#pragma unroll
                for (int d0 = 0; d0 < NDV; ++d0) { vf[k2][2 * d0] = vtr(vlane + d0 * 4096 + (2 * h + k2) * 1024); vf[k2][2 * d0 + 1] = vtr(vlane + d0 * 4096 + (2 * h + k2) * 1024 + 512); }
            __builtin_amdgcn_sched_barrier(0);
#pragma unroll
            for (int k2 = 0; k2 < 2; ++k2)
#pragma unroll
                for (int d0 = 0; d0 < NDV; ++d0) {
                    const s16x4 lo = vf[k2][2 * d0], hv = vf[k2][2 * d0 + 1];
                    const bf16x8 vfr = (bf16x8){lo[0], lo[1], lo[2], lo[3], hv[0], hv[1], hv[2], hv[3]};
                    o[d0] = __builtin_amdgcn_mfma_f32_32x32x16_bf16(__builtin_bit_cast(bf16x8, pw[2 * h + k2]), vfr, o[d0], 0, 0, 0);
                }
            __builtin_amdgcn_sched_barrier(0);
        }
    }
}

__device__ __forceinline__ void diff_unit(const bf16* proj, bf16* mix, const float* sgain, float lam, int b, int h, int qb, LAS unsigned char* lds, int& it) {
    const int tid = threadIdx.x, lane = tid & 63, r32 = lane & 31, hi = lane >> 5; const int wid = __builtin_amdgcn_readfirstlane(tid >> 6);
    LAS float* wsf = (LAS float*)(lds + 49152 + wid * 256);
    LAS unsigned* stash = (LAS unsigned*)(lds + 51200 + wid * 8192);
    const bf16* base = proj + (size_t)b * SEQ * INC;
    const int q0 = qb * 256, NT = 4 * qb + 4, qw = q0 + wid * 32;
    const int vlo = ((lane >> 4) & 1) * 32 + (lane & 3) * 8 + (4 * hi + ((lane & 15) >> 2)) * 64;
    const int vcol = 1024 + h * 128;
#pragma nounroll
    for (int c = 0; c < 2; ++c) {
        bf16x8 qr[4];
#pragma unroll
        for (int d0 = 0; d0 < 4; ++d0) qr[d0] = *(const bf16x8*)(base + (size_t)(qw + r32) * INC + h * 128 + c * 64 + d0 * 16 + hi * 8);
        const int kcol = 512 + h * 128 + c * 64;
        const bf16* kp = base + (size_t)lane * INC + kcol + wid * 8;
        const bf16* vp0 = base + (size_t)(16 * (wid & 3) + (lane >> 2)) * INC + vcol + (wid >> 2) * 32 + (lane & 3) * 8;
        const bf16* vp1 = vp0 + 64;
        f32x16 o[4]; o[0] = f32x16{}; o[1] = f32x16{}; o[2] = f32x16{}; o[3] = f32x16{};
        float mrow = NEGB, lrow = 0.f;
        v4u kreg = *(const v4u*)kp, vreg0 = *(const v4u*)vp0, vreg1 = *(const v4u*)vp1;
#pragma nounroll
        for (int t = 0; t < NT; ++t) {
            const int buf = it & 1; ++it;
            LAS unsigned char* Kb = lds + buf * 8192; LAS unsigned char* Vb = lds + 16384 + buf * 16384;
            *(LAS v4u*)(Kb + wid * 1024 + lane * 16) = kreg;
            *(LAS v4u*)(Vb + wid * 1024 + lane * 16) = vreg0;
            *(LAS v4u*)(Vb + (wid + 8) * 1024 + lane * 16) = vreg1;
            __syncthreads();
            if (t + 1 < NT) { const size_t adv = (size_t)(t + 1) * 64 * INC; kreg = *(const v4u*)(kp + adv); vreg0 = *(const v4u*)(vp0 + adv); vreg1 = *(const v4u*)(vp1 + adv); }
            if (64 * t <= qw + 31) {
                bf16x8 kf[8];
#pragma unroll
                for (int d0 = 0; d0 < 4; ++d0) { kf[2 * d0] = *(const LAS bf16x8*)(Kb + hi * 1024 + r32 * 16 + d0 * 2048); kf[2 * d0 + 1] = *(const LAS bf16x8*)(Kb + hi * 1024 + r32 * 16 + d0 * 2048 + 512); }
                __builtin_amdgcn_sched_barrier(0);
                attn_tile<4>(o, mrow, lrow, kf, qr, (lds_cptr)(Vb + vlo), wsf, qw + r32, 64 * t, 1 << 28, 64 * t + 63 > qw, hi, r32);
            }
        }
        const float ltot = swap_add(lrow);
        if (hi == 0) wsf[r32] = 1.0f / ltot;
        float il[16];
#pragma unroll
        for (int r = 0; r < 16; ++r) il[r] = wsf[crow(r, hi)];
        if (c == 0) {
#pragma unroll
            for (int d0 = 0; d0 < 4; ++d0)
#pragma unroll
                for (int r = 0; r < 16; r += 2) stash[(d0 * 8 + (r >> 1)) * 64 + lane] = cvtpk(o[d0][r] * il[r], o[d0][r + 1] * il[r + 1]);
        } else {
            float ssq[16];
#pragma unroll
            for (int r = 0; r < 16; ++r) ssq[r] = 0.f;
#pragma unroll
            for (int d0 = 0; d0 < 4; ++d0)
#pragma unroll
                for (int r = 0; r < 16; r += 2) { const unsigned w = stash[(d0 * 8 + (r >> 1)) * 64 + lane];
                    const float a0 = __uint_as_float(w << 16) - lam * (o[d0][r] * il[r]), a1 = __uint_as_float(w & 0xffff0000u) - lam * (o[d0][r + 1] * il[r + 1]);
                    o[d0][r] = a0; o[d0][r + 1] = a1; ssq[r] += a0 * a0; ssq[r + 1] += a1 * a1; }
#pragma unroll
            for (int r = 0; r < 16; ++r) {
#pragma unroll
                for (int off = 1; off < 32; off <<= 1) ssq[r] += __shfl_xor(ssq[r], off);
                ssq[r] = 0.8f / sqrtf(ssq[r] * (1.0f / 128.0f) + 1e-5f); }
            int qw2 = qw; asm volatile("" : "+v"(qw2));
            bf16* orow = mix + (size_t)(b * SEQ + qw2 + 4 * hi) * DM + h * 128 + r32;
#pragma unroll
            for (int d0 = 0; d0 < 4; ++d0) { const float g = sgain[d0 * 32 + r32];
#pragma unroll
                for (int r = 0; r < 16; ++r) orow[(size_t)crow(r, 0) * DM + d0 * 32] = (bf16)cvtpk(o[d0][r] * ssq[r] * g, 0.f); }
        }
    }
}

template <int NQ>
__device__ __forceinline__ void dil_job(const bf16* base, int dl, int res, int qs, int chunk, int br, int head, LAS unsigned char* vreg, LAS float* wsf, LAS bf16* obuf, LAS float* lsebuf,
                                        int lane, int r32, int hi) {
    const int qcol = 1536 + head * 64, kcol = 2048 + head * 64, vcol = 2560 + head * 64;
    const int vlo = ((lane >> 4) & 1) * 32 + (lane & 3) * 8 + (4 * hi + ((lane & 15) >> 2)) * 64;
    bf16x8 qr[NQ][4];
#pragma unroll
    for (int t = 0; t < NQ; ++t)
#pragma unroll
        for (int d0 = 0; d0 < 4; ++d0) qr[t][d0] = *(const bf16x8*)(base + (size_t)((qs + 32 * t + r32) * dl + res) * INC + qcol + d0 * 16 + hi * 8);
    f32x16 o[NQ][2]; float mrow[NQ], lrow[NQ];
#pragma unroll
    for (int t = 0; t < NQ; ++t) { o[t][0] = f32x16{}; o[t][1] = f32x16{}; mrow[t] = NEGB; lrow[t] = 0.f; }
    const int kt0 = (qs >= 128 ? qs - 128 : 0) >> 6, kt1 = (qs + 32 * NQ - 1) >> 6;
    const size_t rstep = (size_t)dl * INC;
    const bf16* rowp = base + (size_t)((lane >> 3) * dl + res) * INC + (lane & 7) * 8;
    const int kr = lane >> 3, kc = lane & 7;
#pragma nounroll
    for (int kt = kt0; kt <= kt1; ++kt) {
        const int kbase = kt * 64;
        v4u kn[8], vn[8];
        { const bf16* gp = rowp + (size_t)kbase * rstep + kcol;
#pragma unroll
            for (int i = 0; i < 8; ++i) { kn[i] = *(const v4u*)gp; vn[i] = *(const v4u*)(gp + 512); gp += 8 * rstep; asm volatile("" : "+v"(gp)); } }
        int krl = kr, kcl = kc, rl = r32; asm volatile("" : "+v"(krl), "+v"(kcl), "+v"(rl));
#pragma unroll
        for (int i = 0; i < 8; ++i) { const int key = 8 * i + krl; *(LAS v4u*)(vreg + key * 128 + ((kcl ^ ((key >> 1) & 7)) * 16)) = kn[i]; }
        bf16x8 kf[8];
#pragma unroll
        for (int d0 = 0; d0 < 4; ++d0)
#pragma unroll
            for (int hf = 0; hf < 2; ++hf) { const int key = 32 * hf + rl; kf[2 * d0 + hf] = *(const LAS bf16x8*)(vreg + key * 128 + (((2 * d0 + hi) ^ ((key >> 1) & 7)) * 16)); }
        __builtin_amdgcn_sched_barrier(0);
#pragma unroll
        for (int i = 0; i < 8; ++i) { const int key = 8 * i + krl; *(LAS v4u*)(vreg + (kcl >> 2) * 4096 + (key >> 4) * 1024 + (key & 15) * 64 + (kcl & 3) * 16) = vn[i]; }
#pragma unroll
        for (int t = 0; t < NQ; ++t) {
            const int qmin = qs + 32 * t, qmax = qmin + 31; int hm = 0, mm = 0;
#pragma unroll
            for (int h = 0; h < 2; ++h) { const int kmin = kbase + 32 * h, kmax = kmin + 31;
                const bool actv = !(kmin > qmax || kmax < qmin - 128), full = (kmax <= qmin) && (kmin >= qmax - 128);
                if (actv) { hm |= 1 << h; if (!full) mm |= 1 << h; } }
            if (hm) { f32x16 p0, p1; v4u pw[4];
                attn_qk_h(p0, p1, kf, qr[t], hm);
                attn_smx_h<2>(o[t], mrow[t], lrow[t], p0, p1, pw, wsf, qs + 32 * t + r32, kbase, 128, hm, mm, hi, r32);
                attn_pv_h<2>(o[t], pw, (lds_cptr)(vreg + vlo), hm); }
        }
    }
    int hil = hi, r32l = r32;
    asm volatile("" : "+v"(qs), "+v"(hil), "+v"(r32l));
#pragma unroll
    for (int t = 0; t < NQ; ++t) {
        const float ltot = swap_add(lrow[t]);
        if (hi == 0) { wsf[r32] = 1.0f / ltot; wsf[32 + r32] = mrow[t] + __builtin_amdgcn_logf(ltot); }
#pragma unroll
        for (int r = 0; r < 16; ++r) {
            const int row = crow(r, hil); const int tok = (qs + 32 * t + row) * dl + res - chunk * 512;
            const float il = wsf[row], lb = wsf[32 + row];
            float n0, n1, ln;
            if (br == 0) { n0 = o[t][0][r] * il; n1 = o[t][1][r] * il; ln = lb; }
            else {
                const float la = lsebuf[tok];
                const float oa0 = __uint_as_float((unsigned)obuf[tok * 64 + r32l] << 16), oa1 = __uint_as_float((unsigned)obuf[tok * 64 + 32 + r32l] << 16);
                const float mx = fmaxf(la, lb), ea = __builtin_amdgcn_exp2f(la - mx), eb = __builtin_amdgcn_exp2f(lb - mx), den = ea + eb, rden = 1.0f / den;
                const float wa = ea * rden, wb = eb * rden * il;
                n0 = wa * oa0 + wb * o[t][0][r]; n1 = wa * oa1 + wb * o[t][1][r]; ln = mx + __builtin_amdgcn_logf(den);
            }
            obuf[tok * 64 + r32l] = (bf16)cvtpk(n0, 0.f); obuf[tok * 64 + 32 + r32l] = (bf16)cvtpk(n1, 0.f);
            if (r32l == 0) lsebuf[tok] = ln;
        }
    }
}
__device__ __forceinline__ void dil_unit(const bf16* proj, bf16* mix, int b, int head, int chunk, LAS unsigned char* lds) {
    int tid = threadIdx.x; asm volatile("" : "+v"(tid));
    const int lane = tid & 63, r32 = lane & 31, hi = lane >> 5; const int wid = __builtin_amdgcn_readfirstlane(tid >> 6);
    LAS unsigned char* vreg = lds + wid * 8192;
    LAS float* wsf = (LAS float*)(lds + 65536 + wid * 256);
    LAS bf16* obuf = (LAS bf16*)(lds + 67584);
    LAS float* lsebuf = (LAS float*)(lds + 133120);
    const bf16* base = proj + (size_t)b * SEQ * INC;
    dil_job<2>(base, 1, 0, chunk * 512 + 64 * wid, chunk, 0, head, vreg, wsf, obuf, lsebuf, lane, r32, hi);
    __syncthreads();
    dil_job<2>(base, 4, wid & 3, chunk * 128 + 64 * (wid >> 2), chunk, 1, head, vreg, wsf, obuf, lsebuf, lane, r32, hi);
    __syncthreads();
    dil_job<1>(base, 16, wid, chunk * 32, chunk, 2, head, vreg, wsf, obuf, lsebuf, lane, r32, hi);
    dil_job<1>(base, 16, wid + 8, chunk * 32, chunk, 2, head, vreg, wsf, obuf, lsebuf, lane, r32, hi);
    __syncthreads();
    bf16* orow = mix + (size_t)(b * SEQ + chunk * 512) * DM + 512 + head * 64;
#pragma unroll
    for (int i = 0; i < 8; ++i) { const int idx = tid + 512 * i, tok = idx >> 3, ch = idx & 7;
        const v4u v = *(const LAS v4u*)((LAS unsigned char*)obuf + tok * 128 + ch * 16); *(v4u*)(orow + (size_t)tok * DM + ch * 8) = v; }
    __syncthreads();
}

__device__ __forceinline__ void p0_transpose_item(const float* W, const float* gain, int K, int N, bf16* WT, int mode, LAS float* scr, int item, int lane) {
    const int nblk = N / 32, kb = item / nblk, nb = item % nblk, k0 = 64 * kb, n0 = 32 * nb;
#pragma unroll
    for (int i = 0; i < 8; ++i) { const int kk = 8 * i + (lane >> 3), c4 = (lane & 7) * 4;
        f32x4 w = __builtin_nontemporal_load((const f32x4*)(W + (size_t)(k0 + kk) * N + n0 + c4)); if (gain) w = w * gain[k0 + kk];
        scr[kk * 33 + c4] = w[0]; scr[kk * 33 + c4 + 1] = w[1]; scr[kk * 33 + c4 + 2] = w[2]; scr[kk * 33 + c4 + 3] = w[3]; }
    LDS_WAIT(); asm volatile("" ::: "memory");
    const int c = lane & 7;
    const int rbase = mode == 0 ? n0 : ((n0 >> 7) * 256 + (n0 & 127) + (mode == 2 ? 128 : 0));
#pragma unroll
    for (int j = 0; j < 4; ++j) { const int n = (lane >> 3) + 8 * j; const LAS float* s = scr + (8 * c) * 33 + n;
        v4u o; o.x = pk2(s[0 * 33], s[1 * 33]); o.y = pk2(s[2 * 33], s[3 * 33]); o.z = pk2(s[4 * 33], s[5 * 33]); o.w = pk2(s[6 * 33], s[7 * 33]);
        *(v4u*)(WT + (size_t)(rbase + n) * K + k0 + 8 * c) = o; }
    LDS_WAIT(); asm volatile("" ::: "memory");
}

#define XB_TMO      128
#define XB_XCNT(j)  (256  + 64 * (j))
#define XB_XSUB(j)  (1280 + 64 * (j))
#define XB_XGEN(j)  (2304 + 64 * (j))
#define XB_TOP      3328
#define XB_TOPGEN   3392
#define XCD_BAR_WORDS 3456
#define XB_SPIN_CAP (1u << 18)

__device__ __forceinline__ unsigned xb_ld(unsigned* p)              { return __hip_atomic_load(p, __ATOMIC_RELAXED, __HIP_MEMORY_SCOPE_AGENT); }
__device__ __forceinline__ unsigned xb_add(unsigned* p, unsigned v) { return __hip_atomic_fetch_add(p, v, __ATOMIC_RELAXED, __HIP_MEMORY_SCOPE_AGENT); }
__device__ __forceinline__ unsigned xb_xcc_id() { return (unsigned)__builtin_amdgcn_s_getreg((3 << 11) | 20) & 0xFu; }
#define XB_SPIN(cond, bar) do { unsigned _sp = 0; while (cond) { __builtin_amdgcn_s_sleep(1); \
    if ((++_sp & 255u) == 0u) { if (xb_ld(&(bar)[XB_TMO])) break; if (_sp > XB_SPIN_CAP) { atomicAdd(&(bar)[XB_TMO], 1u); break; } } } } while (0)

struct XcdBarrier {
    unsigned* bar; unsigned x;
    volatile LAS unsigned* st;
};

__device__ __forceinline__ XcdBarrier xcd_barrier_post(unsigned* bar, volatile LAS unsigned* st) {
    XcdBarrier b; b.bar = bar; b.x = xb_xcc_id(); b.st = st;
    if (threadIdx.x == 0) (void)xb_add(&bar[XB_XCNT(b.x)], 1u);
    return b;
}
__device__ __forceinline__ void xcd_barrier_complete(unsigned* bar, unsigned x, unsigned& nloc, unsigned& nx) {
    const unsigned G = gridDim.x * gridDim.y * gridDim.z;
    unsigned sum, cnt, mine, sp = 0u;
    for (;;) {
        sum = 0u; cnt = 0u; mine = 0u;
#pragma unroll
        for (unsigned j = 0; j < 16; ++j) { const unsigned c = xb_ld(&bar[XB_XCNT(j)]); sum += c; cnt += (c > 0u) ? 1u : 0u; mine = (j == x) ? c : mine; }
        if (sum == G) break;
        __builtin_amdgcn_s_sleep(1);
        if ((++sp & 255u) == 0u) { if (xb_ld(&bar[XB_TMO])) break; if (sp > XB_SPIN_CAP) { atomicAdd(&bar[XB_TMO], 1u); break; } }
    }
    nloc = mine > 0u ? mine : 1u; nx = cnt > 0u ? cnt : 1u;
}

__device__ __forceinline__ void xcd_barrier(const XcdBarrier& b) {
    asm volatile("s_waitcnt vmcnt(0)" ::: "memory");
    __syncthreads();
    if (threadIdx.x == 0) {
        unsigned* bar = b.bar;
        __builtin_amdgcn_s_waitcnt(0);
        unsigned nloc = b.st[0], nx = b.st[1];
        if (nloc == 0u) { xcd_barrier_complete(bar, b.x, nloc, nx); b.st[0] = nloc; b.st[1] = nx; }
        const unsigned old = xb_add(&bar[XB_XSUB(b.x)], 1u);
        const unsigned gen = old / nloc;
        if (old + 1u == (gen + 1u) * nloc) {
            __builtin_amdgcn_fence(__ATOMIC_RELEASE, "agent");
            asm volatile("s_waitcnt vmcnt(0)" ::: "memory");
            const unsigned og = xb_add(&bar[XB_TOP], 1u);
            const unsigned tg = og / nx;
            if (og + 1u == (tg + 1u) * nx) xb_add(&bar[XB_TOPGEN], 1u);
            else XB_SPIN(xb_ld(&bar[XB_TOPGEN]) == tg, bar);
            __builtin_amdgcn_fence(__ATOMIC_ACQUIRE, "agent");
            xb_add(&bar[XB_XGEN(b.x)], 1u);
            asm volatile("s_waitcnt vmcnt(0)" ::: "memory");
        } else {
            XB_SPIN(xb_ld(&bar[XB_XGEN(b.x)]) == gen, bar);
            __builtin_amdgcn_fence(__ATOMIC_ACQUIRE, "agent");
            asm volatile("s_waitcnt vmcnt(0)" ::: "memory");
        }
    }
    __syncthreads();
}

struct Args { const float* in[19]; float* out; unsigned char* ws; int ph_lo, ph_hi; };

__global__ void __launch_bounds__(512, 2) mega_fwd(Args args) {
    extern __shared__ __attribute__((aligned(16))) unsigned char lds_raw[];
    LAS unsigned char* lds = (LAS unsigned char*)lds_raw;
    cg::grid_group grid = cg::this_grid();
    const int tid = threadIdx.x; const int wave = __builtin_amdgcn_readfirstlane(tid >> 6);
#define LANE_LOCAL() int lane = threadIdx.x; asm volatile("" : "+v"(lane)); lane &= 63
    const int G = gridDim.x, bx = blockIdx.x; const int vcu = (G % 8 == 0) ? (bx % 8) * (G / 8) + bx / 8 : bx;
    unsigned char* ws = args.ws;
    float* SS = (float*)(ws + WS_SS); float* CS = (float*)(ws + WS_CS);
    bf16* WGU1 = (bf16*)(ws + WS_WGU1); bf16* WD1 = (bf16*)(ws + WS_WD1); bf16* WIN = (bf16*)(ws + WS_WIN); bf16* WOUT = (bf16*)(ws + WS_WOUT); bf16* WGU2 = (bf16*)(ws + WS_WGU2); bf16* WD2 = (bf16*)(ws + WS_WD2);
    bf16* XB = (bf16*)(ws + WS_XB); bf16* MIX = (bf16*)(ws + WS_MIX); bf16* HP = (bf16*)(ws + WS_HP);
    const float* x = args.in[0]; float* out = args.out;
    const int lo = args.ph_lo, hi_ = args.ph_hi;
    if (tid < 16) ((LAS unsigned*)(lds + LDS_MISC))[tid] = 0u;
    __syncthreads();
    XcdBarrier xbar = xcd_barrier_post((unsigned*)(ws + WS_BAR), (volatile LAS unsigned*)(lds + LDS_MISC));
#ifndef PH_MASK
#define PH_MASK 0x1ff
#endif
#define IN(k) (((PH_MASK >> (k)) & 1) && lo <= (k) && (k) < hi_)
#ifndef REP_MASK
#define REP_MASK 0
#endif
#define REPS(k) for (int rep_ = 0; rep_ < 1 + ((REP_MASK >> (k)) & 1); ++rep_)
#define SEAM(k) do { if (IN(k) && IN((k) + 1)) { if ((k) == 0 && hi_ > 64) grid.sync(); else xcd_barrier(xbar); } } while (0)

    if (IN(0)) REPS(0) {
        LANE_LOCAL();
        LAS float* scr = (LAS float*)(lds + wave * 16384);
        const int gw = vcu * 8 + wave, NGW = G * 8;
        constexpr int I_GU = (DM / 64) * (DFF / 32), I_D = (DFF / 64) * (DM / 32), I_IN = (DM / 64) * (INC / 32), I_OUT = (DM / 64) * (DM / 32);
        constexpr int NITEMS = 4 * I_GU + 2 * I_D + I_IN + I_OUT;
        for (int it = gw; it < NITEMS; it += NGW) {
            int r = it;
            if (r < I_GU) { p0_transpose_item(args.in[3], args.in[2], DM, DFF, WGU1, 1, scr, r, lane); continue; } r -= I_GU;
            if (r < I_GU) { p0_transpose_item(args.in[4], args.in[2], DM, DFF, WGU1, 2, scr, r, lane); continue; } r -= I_GU;
            if (r < I_D) { p0_transpose_item(args.in[5], nullptr, DFF, DM, WD1, 0, scr, r, lane); continue; } r -= I_D;
            if (r < I_IN) { p0_transpose_item(args.in[7], args.in[6], DM, INC, WIN, 0, scr, r, lane); continue; } r -= I_IN;
            if (r < I_OUT) { p0_transpose_item(args.in[13], nullptr, DM, DM, WOUT, 0, scr, r, lane); continue; } r -= I_OUT;
            if (r < I_GU) { p0_transpose_item(args.in[15], args.in[14], DM, DFF, WGU2, 1, scr, r, lane); continue; } r -= I_GU;
            if (r < I_GU) { p0_transpose_item(args.in[16], args.in[14], DM, DFF, WGU2, 2, scr, r, lane); continue; } r -= I_GU;
            p0_transpose_item(args.in[17], nullptr, DFF, DM, WD2, 0, scr, r, lane);
        }
        for (int m = gw; m < M; m += NGW) {
            const f32x4* xr = (const f32x4*)(x + (size_t)m * DM) + lane; f32x4 v[4]; float s = 0.f;
#pragma unroll
            for (int j = 0; j < 4; ++j) { v[j] = __builtin_nontemporal_load(xr + 64 * j); s += (v[j].x * v[j].x + v[j].y * v[j].y) + (v[j].z * v[j].z + v[j].w * v[j].w); }
            s = wave_sum(s);
            unsigned long long* o8 = (unsigned long long*)(XB + (size_t)m * DM) + lane;
#pragma unroll
            for (int j = 0; j < 4; ++j) o8[64 * j] = (unsigned long long)pk2(v[j].x, v[j].y) | ((unsigned long long)pk2(v[j].z, v[j].w) << 32);
            if (lane < 16) SS[(size_t)m * 16 + lane] = lane == 0 ? s : 0.f;
        }
        const int* pos = (const int*)args.in[1];
        for (int i = (vcu * 512 + tid); i < M * 8; i += G * 512) {
            const int row = i >> 3, f = i & 7;
            float a = -13.122363377404328f * (float)f; a = a * 2.0f; a = a / 16.0f;
            const float inv = expf(a), ang = (float)pos[row] * inv;
            float sn, cn; sincosf(ang, &sn, &cn);
            CS[(size_t)row * 16 + f] = cn; CS[(size_t)row * 16 + 8 + f] = sn;
        }
    }
    SEAM(0);
    if (IN(1)) REPS(1) {
        pg8::Gemm g{XB, WGU1, M, 2 * DFF, DM}; pg8::StaticOrder S; S.init(M, 2 * DFF, G, bx);
        pg8::EpiSwiGLU E{HP, SS, lds};
        pg8::gemm_phase<pg8::EpiSwiGLU, pg8::StaticOrder, true, true>(lds, g, S, E);
    }
    SEAM(1);
    if (IN(2)) {
        pg8::Gemm g{HP, WD1, M, DM, DFF}; pg8::StaticOrder S; S.init(M, DM, G, bx);
        pg8::EpiRes E{XB, SS, 0.5f};
        pg8::gemm_phase<pg8::EpiRes, pg8::StaticOrder, true, true>(lds, g, S, E);
    }
    SEAM(2);
    if (IN(3)) REPS(3) {
        pg8::Gemm g{XB, WIN, M, INC, DM}; pg8::StaticOrder S; S.init(M, INC, G, bx);
        pg8::EpiProj E{HP, SS, CS, C2, lds};
        pg8::gemm_phase<pg8::EpiProj, pg8::StaticOrder, true, true>(lds, g, S, E);
    }
    SEAM(3);
    if (IN(4)) REPS(4) {
        float lam;
        { LANE_LOCAL(); const float a = wave_sum(args.in[8][lane] * args.in[9][lane]), b2 = wave_sum(args.in[10][lane] * args.in[11][lane]); lam = expf(a) - expf(b2) + 0.2f; }
        int it = 0;
#ifndef NO_DIL
        for (int v = vcu; v < 256; v += G) {
            const int bh = v >> 1, c0 = v & 1;
            dil_unit(HP, MIX, bh >> 3, bh & 7, 3 - c0, lds);
            dil_unit(HP, MIX, bh >> 3, bh & 7, c0, lds);
        }
#endif
        __syncthreads();
#ifndef NO_DIFF
        for (int p = vcu; p < 256; p += G) {
            const int b = p >> 4, h = (p >> 2) & 3, s = p & 3;
            diff_unit(HP, MIX, args.in[12], lam, b, h, 7 - s, lds, it);
            diff_unit(HP, MIX, args.in[12], lam, b, h, s, lds, it);
        }
#endif
    }
    SEAM(4);
    if (IN(5)) {
        pg8::Gemm g{MIX, WOUT, M, DM, DM}; pg8::StaticOrder S; S.init(M, DM, G, bx);
        pg8::EpiRes E{XB, SS, 1.0f};
        pg8::gemm_phase<pg8::EpiRes, pg8::StaticOrder, true, true>(lds, g, S, E);
    }
    SEAM(5);
    if (IN(6)) {
        pg8::Gemm g{XB, WGU2, M, 2 * DFF, DM}; pg8::StaticOrder S; S.init(M, 2 * DFF, G, bx);
        pg8::EpiSwiGLU E{HP, SS, lds};
        pg8::gemm_phase<pg8::EpiSwiGLU, pg8::StaticOrder, true, true>(lds, g, S, E);
    }
    SEAM(6);
    if (IN(7)) {
        pg8::Gemm g{HP, WD2, M, DM, DFF}; pg8::StaticOrder S; S.init(M, DM, G, bx);
        pg8::EpiFinal E{XB, out, args.in[18], (unsigned*)SS, (unsigned*)(ws + WS_BAR) + 4096, lds + 131072, 0.5f};
        pg8::gemm_phase<pg8::EpiFinal, pg8::StaticOrder, true, true>(lds, g, S, E);
    }
#undef IN
#undef SEAM
}

#ifndef MK_N_LAUNCHES
#define MK_N_LAUNCHES 1
#endif
extern "C" void kernel_launch(void* const* d_in, const int* in_sizes, int n_in, void* d_out, int out_size, void* d_ws, size_t ws_size, hipStream_t stream) {
    static int grid = 0;
    if (grid == 0) {
        if (n_in != 19 || in_sizes[0] != M * DM || out_size != M * DM || ws_size < WS_END) { fprintf(stderr, "kernel_launch: unexpected shapes (n_in %d, ws %zu)\n", n_in, ws_size); grid = -1; return; }
        int dev = 0, cus = 0, per_cu = 0;
        hipGetDevice(&dev); hipDeviceGetAttribute(&cus, hipDeviceAttributeMultiprocessorCount, dev);
        if (hipFuncSetAttribute((const void*)mega_fwd, hipFuncAttributeMaxDynamicSharedMemorySize, LDS_BYTES) != hipSuccess) { fprintf(stderr, "kernel_launch: hipFuncSetAttribute failed\n"); grid = -1; return; }
        if (hipOccupancyMaxActiveBlocksPerMultiprocessor(&per_cu, (const void*)mega_fwd, 512, LDS_BYTES) != hipSuccess || per_cu < 1) { fprintf(stderr, "kernel_launch: occupancy query says %d\n", per_cu); grid = -1; (void)hipGetLastError(); return; }
        grid = cus;
    }
    if (grid < 0) return;
    Args a{};
    for (int i = 0; i < 19; ++i) a.in[i] = (const float*)d_in[i];
    a.out = (float*)d_out; a.ws = (unsigned char*)d_ws;
#if MK_N_LAUNCHES == 1
    if (hipMemsetAsync((char*)d_ws + WS_BAR, 0, BAR_BYTES, stream) != hipSuccess) { fprintf(stderr, "kernel_launch: memset failed\n"); return; }
    a.ph_lo = 0; a.ph_hi = 8;
    void* kargs[] = {&a};
    hipError_t e = hipLaunchCooperativeKernel((const void*)mega_fwd, dim3(grid), dim3(512), kargs, LDS_BYTES, stream);
    if (e != hipSuccess) fprintf(stderr, "kernel_launch: cooperative launch failed: %s (grid %d)\n", hipGetErrorString(e), grid);
#else
    for (int p = 0; p < 8; ++p) { a.ph_lo = p; a.ph_hi = p + 1; hipLaunchKernelGGL(mega_fwd, dim3(grid), dim3(512), LDS_BYTES, stream, a); }
#endif
}
```

```cpp
#include <hip/hip_runtime.h>
#include <hip/hip_cooperative_groups.h>
#include <cstdio>
#include <cstdint>
#include <cmath>
namespace cg = cooperative_groups;
namespace pg8 {
#define PG8_LAS __attribute__((address_space(3)))
typedef unsigned short bf16_t;
typedef short bf16x8 __attribute__((ext_vector_type(8)));
typedef float f32x4 __attribute__((ext_vector_type(4)));
typedef unsigned u32x4 __attribute__((ext_vector_type(4)));
constexpr int BM = 256, BK = 64, HALF = 128, HTB = HALF * BK * 2  , STAGE_BYTES = 8 * HTB, NXCD = 8, WGM = 8;

__host__ __device__ __forceinline__ int lds_byte(int r, int c) { const int st = (r >> 4) * 2 + (c >> 5), rr = r & 15, cc = c & 31, ob = rr * 64 + cc * 2; return st * 1024 + (ob ^ (((ob >> 9) & 1) << 5)); }
__host__ __device__ __forceinline__ void stage_rc(int b, int& R, int& C) { const int st = b / 1024, sb = b % 1024, swz = sb ^ (((sb >> 9) & 1) << 5); R = (st >> 1) * 16 + swz / 64; C = (st & 1) * 32 + (swz % 64) / 2; }
__host__ __device__ __forceinline__ int perm32(int rho) { const int n = rho >> 4, i = rho & 15; return 8 * (i >> 2) + 4 * n + (i & 3); }

struct Unit { int pm, pn; };
struct Gemm { const bf16_t* A; const bf16_t* Bt; int M, N, K; };

struct StaticOrder {
    int nM, nN, nwg, G, c;
    __host__ __device__ void init(int M, int N, int G_, int c_) { nM = M / BM; nN = N / BM; nwg = nM * nN; G = G_; c = c_; }
    __host__ __device__ bool next(int i, Unit& u) const {
        const long L = (long)i * G + c; if (L >= nwg) return false;
        int wgid = (int)L; { const int q = nwg / NXCD, r = nwg % NXCD, xcd = wgid % NXCD, off = wgid / NXCD; wgid = (xcd < r ? xcd * (q + 1) : r * (q + 1) + (xcd - r) * q) + off; }
        const int nig = WGM * nN, gid = wgid / nig, fm = gid * WGM, gsz = (nM - fm) < WGM ? (nM - fm) : WGM;
        u.pm = fm + ((wgid % nig) % gsz); u.pn = (wgid % nig) / gsz; return true;
    }
    __device__ __forceinline__ void a_ready(const Unit&) const {}
    __device__ __forceinline__ void done(const Unit&) const {}
};

__device__ __forceinline__ unsigned cvt_pk_bf16(float lo, float hi) { unsigned r; asm volatile("v_cvt_pk_bf16_f32 %0, %1, %2" : "=v"(r) : "v"(lo), "v"(hi)); return r; }
typedef float f32x2 __attribute__((ext_vector_type(2)));
__device__ __forceinline__ float rstd_row(const float* ss, int row) {
    const f32x4* p = (const f32x4*)(ss + (size_t)row * 16);
    const f32x4 a = p[0], b = p[1], c = p[2], d = p[3];
    const f32x4 s = (a + b) + (c + d);
    const float t = (s[0] + s[1]) + (s[2] + s[3]);
    return __builtin_amdgcn_rsqf(t * (1.0f / 1024.0f) + 1e-5f);
}
constexpr int EPI_PANEL_OFF = 131072;
__device__ __forceinline__ void panel_fetch(const float* ss, PG8_LAS unsigned char* lds0, const Unit& u, int wid, int lane) {
    const float* src = ss + (size_t)u.pm * BM * 16 + (size_t)wid * 512 + lane * 4;
#pragma unroll
    for (int p = 0; p < 2; ++p)
        __builtin_amdgcn_global_load_lds((const unsigned*)(src + p * 256), (PG8_LAS unsigned*)(lds0 + EPI_PANEL_OFF + (wid * 2 + p) * 1024), 16, 0, 0);
}
__device__ __forceinline__ float rstd_panel(const PG8_LAS unsigned char* lds0, int rl) {
    const PG8_LAS f32x4* p = (const PG8_LAS f32x4*)(lds0 + EPI_PANEL_OFF + rl * 64);
    const f32x4 a = p[0], b = p[1], c = p[2], d = p[3];
    const f32x4 s = (a + b) + (c + d);
    const float t = (s[0] + s[1]) + (s[2] + s[3]);
    return __builtin_amdgcn_rsqf(t * (1.0f / 1024.0f) + 1e-5f);
}
constexpr int EPI_RSTD_OFF = 131072 + 16384;
__device__ __forceinline__ void rstd_table(PG8_LAS unsigned char* lds0, int wr, int wc, int fr, int fq) {
    const int tid = (wr * 4 + wc) * 64 + fq * 16 + fr;
    if (tid < 256) ((PG8_LAS float*)(lds0 + EPI_RSTD_OFF))[tid] = rstd_panel(lds0, tid);
    asm volatile("s_waitcnt lgkmcnt(0)" ::: "memory"); __builtin_amdgcn_s_barrier(); asm volatile("" ::: "memory");
}
struct EpiSwiGLU {
    static constexpr bool PERM = true, AFTER_DRAIN = false, HAS_PRE = true;
    bf16_t* H; const float* ss; PG8_LAS unsigned char* lds0;
    __device__ __forceinline__ void pre(const Unit& u, int wid, int lane) const { panel_fetch(ss, lds0, u, wid, lane); }
    __device__ __forceinline__ void operator()(const f32x4 (&acc)[2][2][4][2], const Unit& u, int wr, int wc, int fr, int fq) const {
        const int row0 = u.pm * BM + wr * 64 + fr; const int col = u.pn * 128 + wc * 32 + 8 * fq;
        const __amdgpu_buffer_rsrc_t hrs = __builtin_amdgcn_make_buffer_rsrc((void*)H, 0, 0x7fffffff, 0x00020000);
        rstd_table(lds0, wr, wc, fr, fq);
        const PG8_LAS float* RS = (const PG8_LAS float*)(lds0 + EPI_RSTD_OFF);
#pragma unroll
        for (int ai = 0; ai < 2; ++ai)
#pragma unroll
            for (int m = 0; m < 4; ++m) {
                const int row = row0 + ai * HALF + m * 16; const float rs = RS[wr * 64 + fr + ai * HALF + m * 16];
                f32x4 hv[2];
#pragma unroll
                for (int n = 0; n < 2; ++n) {
                    const f32x4 g4 = acc[ai][0][m][n] * rs, u4 = acc[ai][1][m][n] * rs, t4 = g4 * -1.4426950408889634f;
                    f32x4 e4; e4[0] = __builtin_amdgcn_exp2f(t4[0]); e4[1] = __builtin_amdgcn_exp2f(t4[1]); e4[2] = __builtin_amdgcn_exp2f(t4[2]); e4[3] = __builtin_amdgcn_exp2f(t4[3]);
                    const f32x4 d4 = e4 + 1.0f;
                    f32x4 r4; r4[0] = __builtin_amdgcn_rcpf(d4[0]); r4[1] = __builtin_amdgcn_rcpf(d4[1]); r4[2] = __builtin_amdgcn_rcpf(d4[2]); r4[3] = __builtin_amdgcn_rcpf(d4[3]);
                    hv[n] = (g4 * r4) * u4;
                }
                u32x4 w; w.x = cvt_pk_bf16(hv[0][0], hv[0][1]); w.y = cvt_pk_bf16(hv[0][2], hv[0][3]); w.z = cvt_pk_bf16(hv[1][0], hv[1][1]); w.w = cvt_pk_bf16(hv[1][2], hv[1][3]);
                __builtin_amdgcn_raw_buffer_store_b128(w, hrs, (unsigned)((row * 2816 + col) * 2), 0, 16);
            }
    }
};
struct EpiRes {
    static constexpr bool PERM = true, AFTER_DRAIN = false, HAS_PRE = false;
    bf16_t* xb; float* ss; float alpha;
    __device__ __forceinline__ void operator()(const f32x4 (&acc)[2][2][4][2], const Unit& u, int wr, int wc, int fr, int fq) const {
        const int row0 = u.pm * BM + wr * 64 + fr;
        u32x4 rv[2][4][2];
#pragma unroll
        for (int ai = 0; ai < 2; ++ai)
#pragma unroll
            for (int m = 0; m < 4; ++m)
#pragma unroll
                for (int bj = 0; bj < 2; ++bj) rv[ai][m][bj] = *(const u32x4*)(xb + (size_t)(row0 + ai * HALF + m * 16) * 1024 + u.pn * BM + bj * HALF + wc * 32 + 8 * fq);
#pragma unroll
        for (int ai = 0; ai < 2; ++ai)
#pragma unroll
            for (int m = 0; m < 4; ++m) {
                const int row = row0 + ai * HALF + m * 16; float sq = 0.f;
#pragma unroll
                for (int bj = 0; bj < 2; ++bj) {
                    const size_t off = (size_t)row * 1024 + u.pn * BM + bj * HALF + wc * 32 + 8 * fq;
                    const u32x4 r = rv[ai][m][bj];
                    const f32x4 a0 = {__uint_as_float(r.x << 16), __uint_as_float(r.x & 0xffff0000u), __uint_as_float(r.y << 16), __uint_as_float(r.y & 0xffff0000u)};
                    const f32x4 a1 = {__uint_as_float(r.z << 16), __uint_as_float(r.z & 0xffff0000u), __uint_as_float(r.w << 16), __uint_as_float(r.w & 0xffff0000u)};
                    const f32x4 v0 = a0 + acc[ai][bj][m][0] * alpha, v1 = a1 + acc[ai][bj][m][1] * alpha;
                    u32x4 w; w.x = cvt_pk_bf16(v0[0], v0[1]); w.y = cvt_pk_bf16(v0[2], v0[3]); w.z = cvt_pk_bf16(v1[0], v1[1]); w.w = cvt_pk_bf16(v1[2], v1[3]);
                    *(u32x4*)(xb + off) = w;
                    sq += (v0[0] * v0[0] + v0[1] * v0[1]) + (v0[2] * v0[2] + v0[3] * v0[3]) + (v1[0] * v1[0] + v1[1] * v1[1]) + (v1[2] * v1[2] + v1[3] * v1[3]);
                }
                sq += __shfl_xor(sq, 16); sq += __shfl_xor(sq, 32);
                if (fq == 0) ss[(size_t)row * 16 + u.pn * 4 + wc] = sq;
            }
    }
};
struct EpiFinal {
    static constexpr bool PERM = true, AFTER_DRAIN = false, HAS_PRE = false;
    const bf16_t* xb; float* out; const float* gain; unsigned* slots; unsigned* cnt; PG8_LAS unsigned char* elds; float alpha;
    __device__ __forceinline__ void operator()(f32x4 (&acc)[2][2][4][2], const Unit& u, int wr, int wc, int fr, int fq) const {
        PG8_LAS float* P = (PG8_LAS float*)elds;
        PG8_LAS float* S = P + 1024;
        const int wid = wr * 4 + wc, lane = fq * 16 + fr, tid = wid * 64 + lane;
        const int row0 = u.pm * BM + wr * 64 + fr;
        u32x4 rv[2][4][2];
#pragma unroll
        for (int ai = 0; ai < 2; ++ai)
#pragma unroll
            for (int m = 0; m < 4; ++m)
#pragma unroll
                for (int bj = 0; bj < 2; ++bj) rv[ai][m][bj] = *(const u32x4*)(xb + (size_t)(row0 + ai * HALF + m * 16) * 1024 + u.pn * BM + bj * HALF + wc * 32 + 8 * fq);
#pragma unroll
        for (int ai = 0; ai < 2; ++ai)
#pragma unroll
            for (int m = 0; m < 4; ++m) {
                float sq = 0.f;
#pragma unroll
                for (int bj = 0; bj < 2; ++bj) {
                    const u32x4 r = rv[ai][m][bj];
                    const f32x4 a0 = {__uint_as_float(r.x << 16), __uint_as_float(r.x & 0xffff0000u), __uint_as_float(r.y << 16), __uint_as_float(r.y & 0xffff0000u)};
                    const f32x4 a1 = {__uint_as_float(r.z << 16), __uint_as_float(r.z & 0xffff0000u), __uint_as_float(r.w << 16), __uint_as_float(r.w & 0xffff0000u)};
                    const f32x4 v0 = a0 + acc[ai][bj][m][0] * alpha, v1 = a1 + acc[ai][bj][m][1] * alpha;
                    acc[ai][bj][m][0] = v0; acc[ai][bj][m][1] = v1;
                    sq += (v0[0] * v0[0] + v0[1] * v0[1]) + (v0[2] * v0[2] + v0[3] * v0[3]) + (v1[0] * v1[0] + v1[1] * v1[1]) + (v1[2] * v1[2] + v1[3] * v1[3]);
                }
                sq += __shfl_xor(sq, 16); sq += __shfl_xor(sq, 32);
                if (fq == 0) P[(ai * HALF + wr * 64 + m * 16 + fr) * 4 + wc] = sq;
            }
        asm volatile("s_waitcnt lgkmcnt(0)" ::: "memory"); __builtin_amdgcn_s_barrier(); asm volatile("" ::: "memory");
        if (tid < 256) { const f32x4 p = *(const PG8_LAS f32x4*)(P + tid * 4); const float sr = (p[0] + p[1]) + (p[2] + p[3]);
            __hip_atomic_store(slots + (size_t)(u.pm * BM + tid) * 16 + u.pn, __float_as_uint(sr), __ATOMIC_RELAXED, __HIP_MEMORY_SCOPE_AGENT); }
        asm volatile("s_waitcnt vmcnt(0)" ::: "memory");
        if (tid < 256 && lane == 0) __hip_atomic_fetch_add(cnt + 64 * u.pm, 1u, __ATOMIC_RELAXED, __HIP_MEMORY_SCOPE_AGENT);
        if (wid == 0) {
            unsigned sp = 0;
            while ((unsigned)__builtin_amdgcn_readfirstlane(__hip_atomic_load(cnt + 64 * u.pm, __ATOMIC_RELAXED, __HIP_MEMORY_SCOPE_AGENT)) < 16u) { __builtin_amdgcn_s_sleep(1); if (++sp > (1u << 20)) break; }
            __builtin_amdgcn_fence(__ATOMIC_ACQUIRE, "agent");
        }
        asm volatile("s_waitcnt vmcnt(0) lgkmcnt(0)" ::: "memory"); __builtin_amdgcn_s_barrier(); asm volatile("" ::: "memory");
        if (tid < 256) { const unsigned* sl = slots + (size_t)(u.pm * BM + tid) * 16; float t = 0.f;
#pragma unroll
            for (int k = 0; k < 4; ++k) t += __uint_as_float(__hip_atomic_load(sl + k, __ATOMIC_RELAXED, __HIP_MEMORY_SCOPE_AGENT));
            S[tid] = __builtin_amdgcn_rsqf(t * (1.0f / 1024.0f) + 1e-5f); }
        asm volatile("s_waitcnt lgkmcnt(0)" ::: "memory"); __builtin_amdgcn_s_barrier(); asm volatile("" ::: "memory");
        f32x4 gv[2][2];
#pragma unroll
        for (int bj = 0; bj < 2; ++bj) { const float* gp = gain + u.pn * BM + bj * HALF + wc * 32 + 8 * fq; gv[bj][0] = *(const f32x4*)gp; gv[bj][1] = *(const f32x4*)(gp + 4); }
#pragma unroll
        for (int ai = 0; ai < 2; ++ai)
#pragma unroll
            for (int m = 0; m < 4; ++m) {
                const int rl = ai * HALF + wr * 64 + m * 16 + fr; const float rs = S[rl];
#pragma unroll
                for (int bj = 0; bj < 2; ++bj) { float* op = out + (size_t)(u.pm * BM + rl) * 1024 + u.pn * BM + bj * HALF + wc * 32 + 8 * fq;
                    *(f32x4*)op = acc[ai][bj][m][0] * rs * gv[bj][0]; *(f32x4*)(op + 4) = acc[ai][bj][m][1] * rs * gv[bj][1]; }
            }
        asm volatile("s_waitcnt lgkmcnt(0)" ::: "memory"); __builtin_amdgcn_s_barrier(); asm volatile("" ::: "memory");
    }
};
struct EpiProj {
    static constexpr bool PERM = true, AFTER_DRAIN = false, HAS_PRE = true;
    bf16_t* P; const float* ss; const float* cs; float qscale; PG8_LAS unsigned char* lds0;
    __device__ __forceinline__ void pre(const Unit& u, int wid, int lane) const { panel_fetch(ss, lds0, u, wid, lane); }
    __device__ __forceinline__ void operator()(const f32x4 (&acc)[2][2][4][2], const Unit& u, int wr, int wc, int fr, int fq) const {
        const int pn = u.pn; const bool rope = !(pn == 4 || pn == 5 || pn >= 10) && ((wc & 1) == 0);
        const float qs = (pn < 2 || pn == 6 || pn == 7) ? qscale : 1.0f;
        const int row0 = u.pm * BM + wr * 64 + fr;
        rstd_table(lds0, wr, wc, fr, fq);
        const PG8_LAS float* RS = (const PG8_LAS float*)(lds0 + EPI_RSTD_OFF);
#pragma unroll
        for (int ai = 0; ai < 2; ++ai)
#pragma unroll
            for (int m = 0; m < 4; ++m) {
                const int row = row0 + ai * HALF + m * 16; const float rs = RS[wr * 64 + fr + ai * HALF + m * 16];
                f32x4 c0 = {1.f, 1.f, 1.f, 1.f}, c1 = c0, s0 = {0.f, 0.f, 0.f, 0.f}, s1 = s0;
                if (rope && fq < 2) { const f32x4* t = (const f32x4*)(cs + (size_t)row * 16); c0 = t[0]; c1 = t[1]; s0 = t[2]; s1 = t[3]; if (fq == 0) { s0 = -s0; s1 = -s1; } }
#pragma unroll
                for (int bj = 0; bj < 2; ++bj) {
                    f32x4 v0 = acc[ai][bj][m][0] * rs, v1 = acc[ai][bj][m][1] * rs;
                    if (rope) { f32x4 p0, p1;
#pragma unroll
                        for (int j = 0; j < 4; ++j) { p0[j] = __shfl_xor(v0[j], 16); p1[j] = __shfl_xor(v1[j], 16); }
                        v0 = v0 * c0 + p0 * s0; v1 = v1 * c1 + p1 * s1; }
                    v0 = v0 * qs; v1 = v1 * qs;
                    u32x4 w; w.x = cvt_pk_bf16(v0[0], v0[1]); w.y = cvt_pk_bf16(v0[2], v0[3]); w.z = cvt_pk_bf16(v1[0], v1[1]); w.w = cvt_pk_bf16(v1[2], v1[3]);
                    *(u32x4*)(P + (size_t)row * 3072 + pn * BM + bj * HALF + wc * 32 + 8 * fq) = w;
                }
            }
    }
};
template <class Epi, class Sched, bool ALIGN_EPI = false, bool SP2 = false>
__device__ __forceinline__ void gemm_phase(PG8_LAS unsigned char* lds, const Gemm g, const Sched& S, const Epi& E) {
    const int tid = threadIdx.x, wid = __builtin_amdgcn_readfirstlane(tid >> 6), lane = tid & 63, wr = wid >> 2, wc = wid & 3, fr = lane & 15, fq = lane >> 4;
    const int K = g.K, nt = K / BK;
    unsigned voffA[2], voffB[2];
#pragma unroll
    for (int i = 0; i < 2; ++i) { int R, C; stage_rc(tid * 16 + i * 8192, R, C); const int Rb = Epi::PERM ? ((R & ~31) + perm32(R & 31)) : R;
        voffA[i] = (unsigned)(R * K + C) * 2u; voffB[i] = (unsigned)(Rb * K + C) * 2u; }
    const size_t kstep = (size_t)(BK * 2);
    const size_t hstep = (size_t)HALF * K * 2;
    const size_t tstep = 2 * hstep;
    const unsigned ldsw = (unsigned)wid * 1024u;
    const int aoff = lds_byte(wr * 64 + fr, fq * 8), boff = lds_byte(wc * 32 + fr, fq * 8);
#define PG8_SA(b, h) (((b) * 2 + (h)) * HTB)
#define PG8_SB(b, h) ((4 + (b) * 2 + (h)) * HTB)
#define PG8_STAGE(bufoff, gbase, voff) do { _Pragma("unroll") for (int _i = 0; _i < 2; ++_i) \
        __builtin_amdgcn_global_load_lds((const unsigned*)((const char*)(gbase) + (voff)[_i]), (PG8_LAS unsigned*)(lds + (bufoff) + ldsw + _i * 8192), 16, 0, 0); } while (0)
#define PG8_LDA(dst, b, h) do { _Pragma("unroll") for (int m = 0; m < 4; ++m) _Pragma("unroll") for (int k = 0; k < 2; ++k) dst[m][k] = *(const PG8_LAS bf16x8*)(lds + PG8_SA(b, h) + aoff + m * 2048 + k * 1024); } while (0)
#define PG8_LDB(dst, b, h) do { _Pragma("unroll") for (int n = 0; n < 2; ++n) _Pragma("unroll") for (int k = 0; k < 2; ++k) dst[n][k] = *(const PG8_LAS bf16x8*)(lds + PG8_SB(b, h) + boff + n * 2048 + k * 1024); } while (0)
#define PG8_MMA(ai, bj, At, Bt) do { __builtin_amdgcn_s_setprio(1); _Pragma("unroll") for (int m = 0; m < 4; ++m) _Pragma("unroll") for (int n = 0; n < 2; ++n) _Pragma("unroll") for (int k = 0; k < 2; ++k) \
        acc[ai][bj][m][n] = __builtin_amdgcn_mfma_f32_16x16x32_bf16(Bt[n][k], At[m][k], acc[ai][bj][m][n], 0, 0, 0); __builtin_amdgcn_s_setprio(0); } while (0)
#define PG8_WAIT_V(n) asm volatile("s_waitcnt vmcnt(" #n ")" ::: "memory")
#define PG8_WAIT_L(n) asm volatile("s_waitcnt lgkmcnt(" #n ")" ::: "memory")
#define PG8_BAR __builtin_amdgcn_s_barrier()
#define PG8_SCHED __builtin_amdgcn_sched_barrier(0)
    Unit cur, nxt; int ui = 0;
    if (!S.next(0, cur)) return;
    if constexpr (Epi::HAS_PRE) E.pre(cur, wid, lane);
    f32x4 acc[2][2][4][2];
#pragma unroll
    for (int a = 0; a < 2; ++a)
#pragma unroll
        for (int b = 0; b < 2; ++b)
#pragma unroll
            for (int m = 0; m < 4; ++m)
#pragma unroll
                for (int n = 0; n < 2; ++n) acc[a][b][m][n] = (f32x4){0.f, 0.f, 0.f, 0.f};
    bf16x8 At[4][2], B0[2][2], B1[2][2];
    const char* cA = (const char*)g.A + (size_t)cur.pm * tstep; const char* cB = (const char*)g.Bt + (size_t)cur.pn * tstep;
    S.a_ready(cur);
    if constexpr (SP2) {
        PG8_STAGE(PG8_SB(0, 0), cB, voffB); PG8_STAGE(PG8_SB(0, 1), cB + hstep, voffB); PG8_STAGE(PG8_SA(0, 0), cA, voffA); PG8_STAGE(PG8_SA(0, 1), cA + hstep, voffA);
        if (wr == 1) PG8_BAR;
        PG8_WAIT_V(2); PG8_BAR;
        PG8_STAGE(PG8_SB(1, 0), cB + kstep, voffB); PG8_STAGE(PG8_SA(1, 0), cA + kstep, voffA); PG8_STAGE(PG8_SB(1, 1), cB + hstep + kstep, voffB);
        PG8_WAIT_V(6); PG8_BAR;
    } else {
        PG8_STAGE(PG8_SB(0, 0), cB, voffB); PG8_STAGE(PG8_SA(0, 0), cA, voffA); PG8_STAGE(PG8_SB(0, 1), cB + hstep, voffB); PG8_STAGE(PG8_SA(0, 1), cA + hstep, voffA);
        if (wr == 1) PG8_BAR;
        PG8_WAIT_V(4); PG8_BAR;
        PG8_STAGE(PG8_SB(1, 0), cB + kstep, voffB); PG8_STAGE(PG8_SA(1, 0), cA + kstep, voffA); PG8_STAGE(PG8_SB(1, 1), cB + hstep + kstep, voffB);
        PG8_WAIT_V(6); PG8_BAR;
    }
    for (;;) {
        const bool has_next = S.next(ui + 1, nxt);
        const char* nA = has_next ? (const char*)g.A + (size_t)nxt.pm * tstep : cA; const char* nB = has_next ? (const char*)g.Bt + (size_t)nxt.pn * tstep : cB;
        for (int t = 0; t < nt; t += 2) {
            const bool last = (t == nt - 2);
            const char* a1 = cA + (size_t)(t + 1) * kstep;
            const char* a2 = last ? nA : cA + (size_t)(t + 2) * kstep; const char* b2 = last ? nB : cB + (size_t)(t + 2) * kstep;
            const char* a3 = a2 + kstep; const char* b3 = b2 + kstep;
            if (last && has_next) S.a_ready(nxt);
            if constexpr (SP2) {
            PG8_LDB(B0, 0, 0); PG8_LDB(B1, 0, 1); PG8_SCHED; PG8_LDA(At, 0, 0); PG8_STAGE(PG8_SA(1, 1), a1 + hstep, voffA);
            PG8_WAIT_V(8); PG8_WAIT_L(0); PG8_BAR; PG8_MMA(0, 0, At, B0); PG8_MMA(0, 1, At, B1); PG8_BAR; PG8_SCHED;
            PG8_LDA(At, 0, 1); PG8_STAGE(PG8_SB(0, 0), b2, voffB); PG8_STAGE(PG8_SB(0, 1), b2 + hstep, voffB); PG8_STAGE(PG8_SA(0, 0), a2, voffA);
            PG8_WAIT_V(8); PG8_WAIT_L(0); PG8_BAR; PG8_MMA(1, 0, At, B0); PG8_MMA(1, 1, At, B1); PG8_BAR; PG8_SCHED;
            PG8_LDB(B0, 1, 0); PG8_LDB(B1, 1, 1); PG8_SCHED; PG8_LDA(At, 1, 0); PG8_STAGE(PG8_SA(0, 1), a2 + hstep, voffA);
            PG8_WAIT_V(8); PG8_WAIT_L(0); PG8_BAR; PG8_MMA(0, 0, At, B0); PG8_MMA(0, 1, At, B1); PG8_BAR; PG8_SCHED;
            PG8_LDA(At, 1, 1); PG8_STAGE(PG8_SB(1, 0), b3, voffB); PG8_STAGE(PG8_SB(1, 1), b3 + hstep, voffB); PG8_STAGE(PG8_SA(1, 0), a3, voffA);
            PG8_WAIT_V(8); PG8_WAIT_L(0); PG8_BAR; PG8_MMA(1, 0, At, B0); PG8_MMA(1, 1, At, B1); PG8_BAR; PG8_SCHED;
            } else {
            PG8_LDB(B0, 0, 0); PG8_SCHED; PG8_LDA(At, 0, 0); PG8_STAGE(PG8_SA(1, 1), a1 + hstep, voffA);
            PG8_WAIT_L(8); PG8_BAR; PG8_WAIT_L(0); PG8_MMA(0, 0, At, B0); PG8_BAR; PG8_SCHED;
            PG8_LDB(B1, 0, 1); PG8_STAGE(PG8_SB(0, 0), b2, voffB);
            PG8_BAR; PG8_WAIT_L(0); PG8_MMA(0, 1, At, B1); PG8_BAR;
            PG8_LDA(At, 0, 1); PG8_STAGE(PG8_SA(0, 0), a2, voffA);
            PG8_BAR; PG8_WAIT_L(0); PG8_MMA(1, 0, At, B0); PG8_BAR; PG8_SCHED;
            PG8_STAGE(PG8_SB(0, 1), b2 + hstep, voffB);
            PG8_WAIT_V(6); PG8_BAR; PG8_MMA(1, 1, At, B1); PG8_BAR;
            PG8_LDB(B0, 1, 0); PG8_SCHED; PG8_LDA(At, 1, 0); PG8_STAGE(PG8_SA(0, 1), a2 + hstep, voffA);
            PG8_WAIT_L(8); PG8_BAR; PG8_WAIT_L(0); PG8_MMA(0, 0, At, B0); PG8_BAR; PG8_SCHED;
            PG8_LDB(B1, 1, 1); PG8_STAGE(PG8_SB(1, 0), b3, voffB);
            PG8_BAR; PG8_WAIT_L(0); PG8_MMA(0, 1, At, B1); PG8_BAR;
            PG8_LDA(At, 1, 1); PG8_STAGE(PG8_SA(1, 0), a3, voffA);
            PG8_BAR; PG8_WAIT_L(0); PG8_MMA(1, 0, At, B0); PG8_BAR; PG8_SCHED;
            PG8_STAGE(PG8_SB(1, 1), b3 + hstep, voffB);
            PG8_WAIT_V(6); PG8_BAR; PG8_MMA(1, 1, At, B1); PG8_BAR;
            }
        }
        if constexpr (ALIGN_EPI) { if (wr == 0) PG8_BAR; }
        if constexpr (!Epi::AFTER_DRAIN) { E(acc, cur, wr, wc, fr, fq); S.done(cur); }
        if (!has_next) break;
        if constexpr (Epi::HAS_PRE) { asm volatile("s_waitcnt lgkmcnt(0)" ::: "memory"); PG8_BAR; E.pre(nxt, wid, lane); }
#pragma unroll
        for (int a = 0; a < 2; ++a)
#pragma unroll
            for (int b = 0; b < 2; ++b)
#pragma unroll
                for (int m = 0; m < 4; ++m)
#pragma unroll
                    for (int n = 0; n < 2; ++n) acc[a][b][m][n] = (f32x4){0.f, 0.f, 0.f, 0.f};
        cur = nxt; cA = nA; cB = nB; ++ui;
        if constexpr (ALIGN_EPI) { if (wr == 1) PG8_BAR; }
    }
    PG8_WAIT_V(0);
    if constexpr (!ALIGN_EPI) { if (wr == 0) PG8_BAR; }
    PG8_BAR;
    if constexpr (Epi::AFTER_DRAIN) { E.fused(acc, cur, wr, wc, fr, fq, lds, wid, lane); S.done(cur); }
#undef PG8_SA
#undef PG8_SB
#undef PG8_STAGE
#undef PG8_LDA
#undef PG8_LDB
#undef PG8_MMA
#undef PG8_WAIT_V
#undef PG8_WAIT_L
#undef PG8_BAR
#undef PG8_SCHED
}
}

constexpr int DM = 1024, BATCH = 16, SEQ = 2048, M = BATCH * SEQ, DFF = 2816, INC = 3072;
constexpr float C2 = 0.125f * 1.4426950408889634f;
constexpr float NEGB = -1.0e30f;

#define GAS __attribute__((address_space(1)))
#define LAS __attribute__((address_space(3)))
typedef unsigned short bf16;
typedef unsigned v4u __attribute__((ext_vector_type(4)));
typedef float f32x4 __attribute__((ext_vector_type(4)));
typedef float f32x16 __attribute__((ext_vector_type(16)));
typedef short bf16x8 __attribute__((ext_vector_type(8)));
typedef short s16x4 __attribute__((ext_vector_type(4)));
typedef LAS const char* lds_cptr;

constexpr size_t MiB = 1u << 20;
constexpr size_t WS_SS = 0, WS_CS = 2 * MiB, WS_WGU1 = 4 * MiB, WS_WD1 = 15 * MiB, WS_WIN = 21 * MiB, WS_WOUT = 27 * MiB, WS_WGU2 = 29 * MiB, WS_WD2 = 40 * MiB;
constexpr size_t WS_XB = 48 * MiB, WS_MIX = 112 * MiB, WS_HP = 176 * MiB, WS_END = 368 * MiB;
constexpr size_t WS_BAR = 47 * MiB, BAR_BYTES = 65536;
constexpr int LDS_BYTES = 151552, LDS_MISC = 151552 - 64;

__device__ __forceinline__ unsigned f2bf(float f) { unsigned u = __builtin_bit_cast(unsigned, f); return (u + 0x7fffu + ((u >> 16) & 1u)) >> 16; }
__device__ __forceinline__ unsigned pk2(float lo, float hi) { return f2bf(lo) | (f2bf(hi) << 16); }
__device__ __forceinline__ unsigned cvtpk(float lo, float hi) { unsigned r; asm volatile("v_cvt_pk_bf16_f32 %0, %1, %2" : "=v"(r) : "v"(lo), "v"(hi)); return r; }
__device__ __forceinline__ float wave_sum(float v) {
#pragma unroll
    for (int o = 1; o < 64; o <<= 1) v += __shfl_xor(v, o);
    return v;
}
#define LDS_WAIT() asm volatile("s_waitcnt lgkmcnt(0)" ::: "memory")

__device__ __forceinline__ int crow(int r, int hi) { return (r & 3) + 8 * (r >> 2) + 4 * hi; }
typedef short v4i16_t __attribute__((ext_vector_type(4)));
__device__ __forceinline__ s16x4 vtr(lds_cptr p) { return __builtin_bit_cast(s16x4, __builtin_amdgcn_ds_read_tr16_b64_v4i16((LAS v4i16_t*)p)); }
__device__ __forceinline__ float swap_add(float v) { auto rr = __builtin_amdgcn_permlane32_swap(__float_as_uint(v), __float_as_uint(v), false, false); return __uint_as_float(rr[0]) + __uint_as_float(rr[1]); }
__device__ __forceinline__ float swap_max(float v) { auto rr = __builtin_amdgcn_permlane32_swap(__float_as_uint(v), __float_as_uint(v), false, false); return fmaxf(__uint_as_float(rr[0]), __uint_as_float(rr[1])); }

__device__ __forceinline__ void attn_qk(f32x16& p0, f32x16& p1, const bf16x8 (&kf)[8], const bf16x8 (&qr)[4]) {
    p0 = f32x16{}; p1 = f32x16{};
#pragma unroll
    for (int d0 = 0; d0 < 4; ++d0) {
        p0 = __builtin_amdgcn_mfma_f32_32x32x16_bf16(kf[2 * d0], qr[d0], p0, 0, 0, 0);
        p1 = __builtin_amdgcn_mfma_f32_32x32x16_bf16(kf[2 * d0 + 1], qr[d0], p1, 0, 0, 0);
    }
}
template <int NDV, bool EARLY = true>
__device__ __forceinline__ void attn_sv(f32x16 (&o)[NDV], float& mrow, float& lrow, f32x16& p0, f32x16& p1, lds_cptr vlane, LAS float* wsf,
                                        int qidx, int kbase, int win, bool need_mask, int hi, int r32) {
    s16x4 vf[2][8];
    if (EARLY) {
#pragma unroll
        for (int ks = 0; ks < 4; ++ks) { vf[0][2 * ks] = vtr(vlane + ks * 1024); vf[0][2 * ks + 1] = vtr(vlane + ks * 1024 + 512); }
        __builtin_amdgcn_sched_barrier(0);
    }
    if (need_mask) {
        int e = qidx - kbase - 4 * hi; asm volatile("" : "+v"(e));
        const int el = e - win;
#pragma unroll
        for (int r = 0; r < 16; ++r) { const int cr = (r & 3) + 8 * (r >> 2);
            p0[r] = (cr <= e && cr >= el) ? p0[r] : NEGB; p1[r] = (cr + 32 <= e && cr + 32 >= el) ? p1[r] : NEGB; }
    }
    float rm;
    { float a = __builtin_fmaxf(__builtin_fmaxf(p0[0], p0[1]), p1[0]), b = __builtin_fmaxf(__builtin_fmaxf(p0[2], p0[3]), p1[1]); a = __builtin_fmaxf(__builtin_fmaxf(a, p1[2]), p1[3]);
#pragma unroll
      for (int r = 4; r < 16; r += 4) { a = __builtin_fmaxf(__builtin_fmaxf(a, p0[r]), p0[r + 1]); b = __builtin_fmaxf(__builtin_fmaxf(b, p0[r + 2]), p0[r + 3]);
          a = __builtin_fmaxf(__builtin_fmaxf(a, p1[r]), p1[r + 1]); b = __builtin_fmaxf(__builtin_fmaxf(b, p1[r + 2]), p1[r + 3]); }
      rm = __builtin_fmaxf(a, b); }
    rm = swap_max(rm);
    const float mn = (rm - mrow > 8.0f) ? rm : mrow, f = __builtin_amdgcn_exp2f(mrow - mn); mrow = mn;
    typedef float f32x2_t __attribute__((ext_vector_type(2)));
    f32x2_t s2 = {0.f, 0.f};
#pragma unroll
    for (int r = 0; r < 16; r += 2) { p0[r] = __builtin_amdgcn_exp2f(p0[r] - mn); p0[r + 1] = __builtin_amdgcn_exp2f(p0[r + 1] - mn); p1[r] = __builtin_amdgcn_exp2f(p1[r] - mn); p1[r + 1] = __builtin_amdgcn_exp2f(p1[r + 1] - mn);
        s2 += (f32x2_t){p0[r], p0[r + 1]}; s2 += (f32x2_t){p1[r], p1[r + 1]}; }
    lrow = lrow * f + (s2.x + s2.y);
    if (__any(f != 1.0f)) {
        if (hi == 0) wsf[r32] = f;
        LAS float* wq = wsf + 4 * hi; asm volatile("" : "+v"(wq));
#pragma unroll
        for (int r = 0; r < 16; ++r) { const float fr_ = wq[(r & 3) + 8 * (r >> 2)];
#pragma unroll
            for (int d = 0; d < NDV; ++d) o[d][r] *= fr_; }
    }
    v4u pw[4];
#pragma unroll
    for (int k = 0; k < 2; ++k) {
        pw[k]     = (v4u){cvtpk(p0[8 * k], p0[8 * k + 1]), cvtpk(p0[8 * k + 2], p0[8 * k + 3]), cvtpk(p0[8 * k + 4], p0[8 * k + 5]), cvtpk(p0[8 * k + 6], p0[8 * k + 7])};
        pw[2 + k] = (v4u){cvtpk(p1[8 * k], p1[8 * k + 1]), cvtpk(p1[8 * k + 2], p1[8 * k + 3]), cvtpk(p1[8 * k + 4], p1[8 * k + 5]), cvtpk(p1[8 * k + 6], p1[8 * k + 7])};
    }
    __builtin_amdgcn_sched_barrier(0);
#pragma unroll
    for (int d0 = 0; d0 < NDV; ++d0) {
        if (EARLY) {
            if (d0 + 1 < NDV) {
#pragma unroll
                for (int ks = 0; ks < 4; ++ks) { vf[(d0 + 1) & 1][2 * ks] = vtr(vlane + (d0 + 1) * 4096 + ks * 1024); vf[(d0 + 1) & 1][2 * ks + 1] = vtr(vlane + (d0 + 1) * 4096 + ks * 1024 + 512); }
            }
        } else {
#pragma unroll
            for (int ks = 0; ks < 4; ++ks) { vf[d0 & 1][2 * ks] = vtr(vlane + d0 * 4096 + ks * 1024); vf[d0 & 1][2 * ks + 1] = vtr(vlane + d0 * 4096 + ks * 1024 + 512); }
        }
        __builtin_amdgcn_sched_barrier(0);
#pragma unroll
        for (int ks = 0; ks < 4; ++ks) {
            const s16x4 lo = vf[d0 & 1][2 * ks], hv = vf[d0 & 1][2 * ks + 1];
            const bf16x8 vfr = (bf16x8){lo[0], lo[1], lo[2], lo[3], hv[0], hv[1], hv[2], hv[3]};
            o[d0] = __builtin_amdgcn_mfma_f32_32x32x16_bf16(__builtin_bit_cast(bf16x8, pw[ks]), vfr, o[d0], 0, 0, 0);
        }
        __builtin_amdgcn_sched_barrier(0);
    }
}
template <int NDV>
__device__ __forceinline__ void attn_tile(f32x16 (&o)[NDV], float& mrow, float& lrow, const bf16x8 (&kf)[8], const bf16x8 (&qr)[4], lds_cptr vlane, LAS float* wsf,
                                          int qidx, int kbase, int win, bool need_mask, int hi, int r32) {
    f32x16 p0, p1;
    attn_qk(p0, p1, kf, qr);
    attn_sv<NDV>(o, mrow, lrow, p0, p1, vlane, wsf, qidx, kbase, win, need_mask, hi, r32);
}

__device__ __forceinline__ void attn_qk_h(f32x16& p0, f32x16& p1, const bf16x8 (&kf)[8], const bf16x8 (&qr)[4], int hm) {
    if (hm & 1) { p0 = f32x16{};
#pragma unroll
        for (int d0 = 0; d0 < 4; ++d0) p0 = __builtin_amdgcn_mfma_f32_32x32x16_bf16(kf[2 * d0], qr[d0], p0, 0, 0, 0); }
    if (hm & 2) { p1 = f32x16{};
#pragma unroll
        for (int d0 = 0; d0 < 4; ++d0) p1 = __builtin_amdgcn_mfma_f32_32x32x16_bf16(kf[2 * d0 + 1], qr[d0], p1, 0, 0, 0); }
}
__device__ __forceinline__ float max16(const f32x16& p) {
    float a = __builtin_fmaxf(__builtin_fmaxf(p[0], p[1]), p[2]), b = __builtin_fmaxf(__builtin_fmaxf(p[3], p[4]), p[5]);
    a = __builtin_fmaxf(__builtin_fmaxf(a, p[6]), p[7]); b = __builtin_fmaxf(__builtin_fmaxf(b, p[8]), p[9]);
    a = __builtin_fmaxf(__builtin_fmaxf(a, p[10]), p[11]); b = __builtin_fmaxf(__builtin_fmaxf(b, p[12]), p[13]);
    return __builtin_fmaxf(__builtin_fmaxf(a, p[14]), __builtin_fmaxf(b, p[15]));
}
template <int NDV>
__device__ __forceinline__ void attn_smx_h(f32x16 (&o)[NDV], float& mrow, float& lrow, f32x16& p0, f32x16& p1, v4u (&pw)[4], LAS float* wsf,
                                           int qidx, int kbase, int win, int hm, int mm, int hi, int r32) {
    int e = qidx - kbase - 4 * hi; asm volatile("" : "+v"(e));
    const int el = e - win;
    float rm = NEGB;
    if (hm & 1) {
        if (mm & 1) {
#pragma unroll
            for (int r = 0; r < 16; ++r) { const int cr = (r & 3) + 8 * (r >> 2); p0[r] = (cr <= e && cr >= el) ? p0[r] : NEGB; } }
        rm = max16(p0);
    }
    if (hm & 2) {
        if (mm & 2) {
#pragma unroll
            for (int r = 0; r < 16; ++r) { const int cr = (r & 3) + 8 * (r >> 2) + 32; p1[r] = (cr <= e && cr >= el) ? p1[r] : NEGB; } }
        rm = __builtin_fmaxf(rm, max16(p1));
    }
    rm = swap_max(rm);
    const float mn = (rm - mrow > 8.0f) ? rm : mrow, f = __builtin_amdgcn_exp2f(mrow - mn); mrow = mn;
    float s = 0.f;
    if (hm & 1) {
#pragma unroll
        for (int r = 0; r < 16; ++r) { p0[r] = __builtin_amdgcn_exp2f(p0[r] - mn); s += p0[r]; }
#pragma unroll
        for (int k = 0; k < 2; ++k) pw[k] = (v4u){cvtpk(p0[8 * k], p0[8 * k + 1]), cvtpk(p0[8 * k + 2], p0[8 * k + 3]), cvtpk(p0[8 * k + 4], p0[8 * k + 5]), cvtpk(p0[8 * k + 6], p0[8 * k + 7])};
    }
    if (hm & 2) {
#pragma unroll
        for (int r = 0; r < 16; ++r) { p1[r] = __builtin_amdgcn_exp2f(p1[r] - mn); s += p1[r]; }
#pragma unroll
        for (int k = 0; k < 2; ++k) pw[2 + k] = (v4u){cvtpk(p1[8 * k], p1[8 * k + 1]), cvtpk(p1[8 * k + 2], p1[8 * k + 3]), cvtpk(p1[8 * k + 4], p1[8 * k + 5]), cvtpk(p1[8 * k + 6], p1[8 * k + 7])};
    }
    lrow = lrow * f + s;
    if (__any(f != 1.0f)) {
        if (hi == 0) wsf[r32] = f;
        LAS float* wq = wsf + 4 * hi; asm volatile("" : "+v"(wq));
#pragma unroll
        for (int r = 0; r < 16; ++r) { const float fr_ = wq[(r & 3) + 8 * (r >> 2)];
#pragma unroll
            for (int d = 0; d < NDV; ++d) o[d][r] *= fr_; }
    }
}
template <int NDV>
__device__ __forceinline__ void attn_pv_h(f32x16 (&o)[NDV], const v4u (&pw)[4], lds_cptr vlane, int hm) {
#pragma unroll
    for (int h = 0; h < 2; ++h) {
        if ((hm >> h) & 1) {
            s16x4 vf[2][2 * NDV];
#pragma unroll
            for (int k2 = 0; k2 < 2; ++k2)
#pragma unroll
                for (int d0 = 0; d0 < NDV; ++d0) { vf[k2][2 * d0] = vtr(vlane + d0 * 4096 + (2 * h + k2) * 1024); vf[k2][2 * d0 + 1] = vtr(vlane + d0 * 4096 + (2 * h + k2) * 1024 + 512); }
            __builtin_amdgcn_sched_barrier(0);
#pragma unroll
            for (int k2 = 0; k2 < 2; ++k2)
#pragma unroll
                for (int d0 = 0; d0 < NDV; ++d0) {
                    const s16x4 lo = vf[k2][2 * d0], hv = vf[k2][2 * d0 + 1];
                    const bf16x8 vfr = (bf16x8){lo[0], lo[1], lo[2], lo[3], hv[0], hv[1], hv[2], hv[3]};
                    o[d0] = __builtin_amdgcn_mfma_f32_32x32x16_bf16(__builtin_bit_cast(bf16x8, pw[2 * h + k2]), vfr, o[d0], 0, 0, 0);
                }
            __builtin_amdgcn_sched_barrier(0);
        }
    }
}

__device__ __forceinline__ void diff_unit(const bf16* proj, bf16* mix, const float* sgain, float lam, int b, int h, int qb, LAS unsigned char* lds, int& it) {
    const int tid = threadIdx.x, lane = tid & 63, r32 = lane & 31, hi = lane >> 5; const int wid = __builtin_amdgcn_readfirstlane(tid >> 6);
    LAS float* wsf = (LAS float*)(lds + 49152 + wid * 256);
    LAS unsigned* stash = (LAS unsigned*)(lds + 51200 + wid * 8192);
    const bf16* base = proj + (size_t)b * SEQ * INC;
    const int q0 = qb * 256, NT = 4 * qb + 4, qw = q0 + wid * 32;
    const int vlo = ((lane >> 4) & 1) * 32 + (lane & 3) * 8 + (4 * hi + ((lane & 15) >> 2)) * 64;
    const int vcol = 1024 + h * 128;
#pragma nounroll
    for (int c = 0; c < 2; ++c) {
        bf16x8 qr[4];
#pragma unroll
        for (int d0 = 0; d0 < 4; ++d0) qr[d0] = *(const bf16x8*)(base + (size_t)(qw + r32) * INC + h * 128 + c * 64 + d0 * 16 + hi * 8);
        const int kcol = 512 + h * 128 + c * 64;
        const bf16* kp = base + (size_t)lane * INC + kcol + wid * 8;
        const bf16* vp0 = base + (size_t)(16 * (wid & 3) + (lane >> 2)) * INC + vcol + (wid >> 2) * 32 + (lane & 3) * 8;
        const bf16* vp1 = vp0 + 64;
        f32x16 o[4]; o[0] = f32x16{}; o[1] = f32x16{}; o[2] = f32x16{}; o[3] = f32x16{};
        float mrow = NEGB, lrow = 0.f;
        v4u kreg = *(const v4u*)kp, vreg0 = *(const v4u*)vp0, vreg1 = *(const v4u*)vp1;
#pragma nounroll
        for (int t = 0; t < NT; ++t) {
            const int buf = it & 1; ++it;
            LAS unsigned char* Kb = lds + buf * 8192; LAS unsigned char* Vb = lds + 16384 + buf * 16384;
            *(LAS v4u*)(Kb + wid * 1024 + lane * 16) = kreg;
            *(LAS v4u*)(Vb + wid * 1024 + lane * 16) = vreg0;
            *(LAS v4u*)(Vb + (wid + 8) * 1024 + lane * 16) = vreg1;
            __syncthreads();
            if (t + 1 < NT) { const size_t adv = (size_t)(t + 1) * 64 * INC; kreg = *(const v4u*)(kp + adv); vreg0 = *(const v4u*)(vp0 + adv); vreg1 = *(const v4u*)(vp1 + adv); }
            if (64 * t <= qw + 31) {
                bf16x8 kf[8];
#pragma unroll
                for (int d0 = 0; d0 < 4; ++d0) { kf[2 * d0] = *(const LAS bf16x8*)(Kb + hi * 1024 + r32 * 16 + d0 * 2048); kf[2 * d0 + 1] = *(const LAS bf16x8*)(Kb + hi * 1024 + r32 * 16 + d0 * 2048 + 512); }
                __builtin_amdgcn_sched_barrier(0);
                attn_tile<4>(o, mrow, lrow, kf, qr, (lds_cptr)(Vb + vlo), wsf, qw + r32, 64 * t, 1 << 28, 64 * t + 63 > qw, hi, r32);
            }
        }
        const float ltot = swap_add(lrow);
        if (hi == 0) wsf[r32] = __builtin_amdgcn_rcpf(ltot);
        float il[16];
#pragma unroll
        for (int r = 0; r < 16; ++r) il[r] = wsf[crow(r, hi)];
        if (c == 0) {
#pragma unroll
            for (int d0 = 0; d0 < 4; ++d0)
#pragma unroll
                for (int r = 0; r < 16; r += 2) stash[(d0 * 8 + (r >> 1)) * 64 + lane] = cvtpk(o[d0][r] * il[r], o[d0][r + 1] * il[r + 1]);
        } else {
            float ssq[16];
#pragma unroll
            for (int r = 0; r < 16; ++r) ssq[r] = 0.f;
#pragma unroll
            for (int d0 = 0; d0 < 4; ++d0)
#pragma unroll
                for (int r = 0; r < 16; r += 2) { const unsigned w = stash[(d0 * 8 + (r >> 1)) * 64 + lane];
                    const float a0 = __uint_as_float(w << 16) - lam * (o[d0][r] * il[r]), a1 = __uint_as_float(w & 0xffff0000u) - lam * (o[d0][r + 1] * il[r + 1]);
                    o[d0][r] = a0; o[d0][r + 1] = a1; ssq[r] += a0 * a0; ssq[r + 1] += a1 * a1; }
#pragma unroll
            for (int r = 0; r < 16; ++r) {
#pragma unroll
                for (int off = 1; off < 32; off <<= 1) ssq[r] += __shfl_xor(ssq[r], off);
                ssq[r] = 0.8f / sqrtf(ssq[r] * (1.0f / 128.0f) + 1e-5f); }
            int qw2 = qw; asm volatile("" : "+v"(qw2));
            bf16* orow = mix + (size_t)(b * SEQ + qw2 + 4 * hi) * DM + h * 128 + r32;
#pragma unroll
            for (int d0 = 0; d0 < 4; ++d0) { const float g = sgain[d0 * 32 + r32];
#pragma unroll
                for (int r = 0; r < 16; ++r) orow[(size_t)crow(r, 0) * DM + d0 * 32] = (bf16)cvtpk(o[d0][r] * ssq[r] * g, 0.f); }
        }
    }
}

template <int NQ>
__device__ __forceinline__ void dil_job(const bf16* base, int dl, int res, int qs, int chunk, int br, int head, LAS unsigned char* vreg, LAS float* wsf, LAS bf16* obuf, LAS float* lsebuf,
                                        int lane, int r32, int hi) {
    const int qcol = 1536 + head * 64, kcol = 2048 + head * 64, vcol = 2560 + head * 64;
    const int vlo = ((lane >> 4) & 1) * 32 + (lane & 3) * 8 + (4 * hi + ((lane & 15) >> 2)) * 64;
    bf16x8 qr[NQ][4];
#pragma unroll
    for (int t = 0; t < NQ; ++t)
#pragma unroll
        for (int d0 = 0; d0 < 4; ++d0) qr[t][d0] = *(const bf16x8*)(base + (size_t)((qs + 32 * t + r32) * dl + res) * INC + qcol + d0 * 16 + hi * 8);
    f32x16 o[NQ][2]; float mrow[NQ], lrow[NQ];
#pragma unroll
    for (int t = 0; t < NQ; ++t) { o[t][0] = f32x16{}; o[t][1] = f32x16{}; mrow[t] = NEGB; lrow[t] = 0.f; }
    const int kt0 = (qs >= 128 ? qs - 128 : 0) >> 6, kt1 = (qs + 32 * NQ - 1) >> 6;
    const size_t rstep = (size_t)dl * INC;
    const bf16* rowp = base + (size_t)((lane >> 3) * dl + res) * INC + (lane & 7) * 8;
    const int kr = lane >> 3, kc = lane & 7;
#pragma nounroll
    for (int kt = kt0; kt <= kt1; ++kt) {
        const int kbase = kt * 64;
        v4u kn[8], vn[8];
        { const bf16* gp = rowp + (size_t)kbase * rstep + kcol;
#pragma unroll
            for (int i = 0; i < 8; ++i) { kn[i] = *(const v4u*)gp; vn[i] = *(const v4u*)(gp + 512); gp += 8 * rstep; asm volatile("" : "+v"(gp)); } }
        int krl = kr, kcl = kc, rl = r32; asm volatile("" : "+v"(krl), "+v"(kcl), "+v"(rl));
#pragma unroll
        for (int i = 0; i < 8; ++i) { const int key = 8 * i + krl; *(LAS v4u*)(vreg + key * 128 + ((kcl ^ ((key >> 1) & 7)) * 16)) = kn[i]; }
        bf16x8 kf[8];
#pragma unroll
        for (int d0 = 0; d0 < 4; ++d0)
#pragma unroll
            for (int hf = 0; hf < 2; ++hf) { const int key = 32 * hf + rl; kf[2 * d0 + hf] = *(const LAS bf16x8*)(vreg + key * 128 + (((2 * d0 + hi) ^ ((key >> 1) & 7)) * 16)); }
        __builtin_amdgcn_sched_barrier(0);
#pragma unroll
        for (int i = 0; i < 8; ++i) { const int key = 8 * i + krl; *(LAS v4u*)(vreg + (kcl >> 2) * 4096 + (key >> 4) * 1024 + (key & 15) * 64 + (kcl & 3) * 16) = vn[i]; }
#pragma unroll
        for (int t = 0; t < NQ; ++t) {
            const int qmin = qs + 32 * t, qmax = qmin + 31; int hm = 0, mm = 0;
#pragma unroll
            for (int h = 0; h < 2; ++h) { const int kmin = kbase + 32 * h, kmax = kmin + 31;
                const bool actv = !(kmin > qmax || kmax < qmin - 128), full = (kmax <= qmin) && (kmin >= qmax - 128);
                if (actv) { hm |= 1 << h; if (!full) mm |= 1 << h; } }
            if (hm) { f32x16 p0, p1; v4u pw[4];
                attn_qk_h(p0, p1, kf, qr[t], hm);
                attn_smx_h<2>(o[t], mrow[t], lrow[t], p0, p1, pw, wsf, qs + 32 * t + r32, kbase, 128, hm, mm, hi, r32);
                attn_pv_h<2>(o[t], pw, (lds_cptr)(vreg + vlo), hm); }
        }
    }
    int hil = hi, r32l = r32;
    asm volatile("" : "+v"(qs), "+v"(hil), "+v"(r32l));
#pragma unroll
    for (int t = 0; t < NQ; ++t) {
        const float ltot = swap_add(lrow[t]);
        if (hi == 0) { wsf[r32] = __builtin_amdgcn_rcpf(ltot); wsf[32 + r32] = mrow[t] + __builtin_amdgcn_logf(ltot); }
#pragma unroll
        for (int r = 0; r < 16; ++r) {
            const int row = crow(r, hil); const int tok = (qs + 32 * t + row) * dl + res - chunk * 512;
            const float il = wsf[row], lb = wsf[32 + row];
            float n0, n1, ln;
            if (br == 0) { n0 = o[t][0][r] * il; n1 = o[t][1][r] * il; ln = lb; }
            else {
                const float la = lsebuf[tok];
                const float oa0 = __uint_as_float((unsigned)obuf[tok * 64 + r32l] << 16), oa1 = __uint_as_float((unsigned)obuf[tok * 64 + 32 + r32l] << 16);
                const float mx = fmaxf(la, lb), ea = __builtin_amdgcn_exp2f(la - mx), eb = __builtin_amdgcn_exp2f(lb - mx), den = ea + eb, rden = __builtin_amdgcn_rcpf(den);
                const float wa = ea * rden, wb = eb * rden * il;
                n0 = wa * oa0 + wb * o[t][0][r]; n1 = wa * oa1 + wb * o[t][1][r]; ln = mx + __builtin_amdgcn_logf(den);
            }
            obuf[tok * 64 + r32l] = (bf16)cvtpk(n0, 0.f); obuf[tok * 64 + 32 + r32l] = (bf16)cvtpk(n1, 0.f);
            if (r32l == 0) lsebuf[tok] = ln;
        }
    }
}
__device__ __forceinline__ void dil_unit(const bf16* proj, bf16* mix, int b, int head, int chunk, LAS unsigned char* lds) {
    int tid = threadIdx.x; asm volatile("" : "+v"(tid));
    const int lane = tid & 63, r32 = lane & 31, hi = lane >> 5; const int wid = __builtin_amdgcn_readfirstlane(tid >> 6);
    LAS unsigned char* vreg = lds + wid * 8192;
    LAS float* wsf = (LAS float*)(lds + 65536 + wid * 256);
    LAS bf16* obuf = (LAS bf16*)(lds + 67584);
    LAS float* lsebuf = (LAS float*)(lds + 133120);
    const bf16* base = proj + (size_t)b * SEQ * INC;
    dil_job<2>(base, 1, 0, chunk * 512 + 64 * wid, chunk, 0, head, vreg, wsf, obuf, lsebuf, lane, r32, hi);
    __syncthreads();
    dil_job<2>(base, 4, wid & 3, chunk * 128 + 64 * (wid >> 2), chunk, 1, head, vreg, wsf, obuf, lsebuf, lane, r32, hi);
    __syncthreads();
    dil_job<1>(base, 16, wid, chunk * 32, chunk, 2, head, vreg, wsf, obuf, lsebuf, lane, r32, hi);
    dil_job<1>(base, 16, wid + 8, chunk * 32, chunk, 2, head, vreg, wsf, obuf, lsebuf, lane, r32, hi);
    __syncthreads();
    bf16* orow = mix + (size_t)(b * SEQ + chunk * 512) * DM + 512 + head * 64;
#pragma unroll
    for (int i = 0; i < 8; ++i) { const int idx = tid + 512 * i, tok = idx >> 3, ch = idx & 7;
        const v4u v = *(const LAS v4u*)((LAS unsigned char*)obuf + tok * 128 + ch * 16); *(v4u*)(orow + (size_t)tok * DM + ch * 8) = v; }
    __syncthreads();
}

__device__ __forceinline__ void p0_transpose_item(const float* W, const float* gain, int K, int N, bf16* WT, int mode, LAS float* scr, int item, int lane) {
    const int nblk = N / 32, kb = item / nblk, nb = item % nblk, k0 = 64 * kb, n0 = 32 * nb;
#pragma unroll
    for (int i = 0; i < 8; ++i) { const int kk = 8 * i + (lane >> 3), c4 = (lane & 7) * 4;
        f32x4 w = __builtin_nontemporal_load((const f32x4*)(W + (size_t)(k0 + kk) * N + n0 + c4)); if (gain) w = w * gain[k0 + kk];
        scr[kk * 33 + c4] = w[0]; scr[kk * 33 + c4 + 1] = w[1]; scr[kk * 33 + c4 + 2] = w[2]; scr[kk * 33 + c4 + 3] = w[3]; }
    LDS_WAIT(); asm volatile("" ::: "memory");
    const int c = lane & 7;
    const int rbase = mode == 0 ? n0 : ((n0 >> 7) * 256 + (n0 & 127) + (mode == 2 ? 128 : 0));
#pragma unroll
    for (int j = 0; j < 4; ++j) { const int n = (lane >> 3) + 8 * j; const LAS float* s = scr + (8 * c) * 33 + n;
        v4u o; o.x = pk2(s[0 * 33], s[1 * 33]); o.y = pk2(s[2 * 33], s[3 * 33]); o.z = pk2(s[4 * 33], s[5 * 33]); o.w = pk2(s[6 * 33], s[7 * 33]);
        *(v4u*)(WT + (size_t)(rbase + n) * K + k0 + 8 * c) = o; }
    LDS_WAIT(); asm volatile("" ::: "memory");
}

#define XB_TMO      128
#define XB_XCNT(j)  (256  + 64 * (j))
#define XB_XSUB(j)  (1280 + 64 * (j))
#define XB_XGEN(j)  (2304 + 64 * (j))
#define XB_TOP      3328
#define XB_TOPGEN   3392
#define XCD_BAR_WORDS 3456
#define XB_SPIN_CAP (1u << 18)

__device__ __forceinline__ unsigned xb_ld(unsigned* p)              { return __hip_atomic_load(p, __ATOMIC_RELAXED, __HIP_MEMORY_SCOPE_AGENT); }
__device__ __forceinline__ unsigned xb_add(unsigned* p, unsigned v) { return __hip_atomic_fetch_add(p, v, __ATOMIC_RELAXED, __HIP_MEMORY_SCOPE_AGENT); }
__device__ __forceinline__ unsigned xb_xcc_id() { return (unsigned)__builtin_amdgcn_s_getreg((3 << 11) | 20) & 0xFu; }
#define XB_SPIN(cond, bar) do { unsigned _sp = 0; while (cond) { __builtin_amdgcn_s_sleep(1); \
    if ((++_sp & 255u) == 0u) { if (xb_ld(&(bar)[XB_TMO])) break; if (_sp > XB_SPIN_CAP) { atomicAdd(&(bar)[XB_TMO], 1u); break; } } } } while (0)

struct XcdBarrier {
    unsigned* bar; unsigned x;
    volatile LAS unsigned* st;
};

__device__ __forceinline__ XcdBarrier xcd_barrier_post(unsigned* bar, volatile LAS unsigned* st) {
    XcdBarrier b; b.bar = bar; b.x = xb_xcc_id(); b.st = st;
    if (threadIdx.x == 0) (void)xb_add(&bar[XB_XCNT(b.x)], 1u);
    return b;
}
__device__ __forceinline__ void xcd_barrier_complete(unsigned* bar, unsigned x, unsigned& nloc, unsigned& nx) {
    const unsigned G = gridDim.x * gridDim.y * gridDim.z;
    unsigned sum, cnt, mine, sp = 0u;
    for (;;) {
        sum = 0u; cnt = 0u; mine = 0u;
#pragma unroll
        for (unsigned j = 0; j < 16; ++j) { const unsigned c = xb_ld(&bar[XB_XCNT(j)]); sum += c; cnt += (c > 0u) ? 1u : 0u; mine = (j == x) ? c : mine; }
        if (sum == G) break;
        __builtin_amdgcn_s_sleep(1);
        if ((++sp & 255u) == 0u) { if (xb_ld(&bar[XB_TMO])) break; if (sp > XB_SPIN_CAP) { atomicAdd(&bar[XB_TMO], 1u); break; } }
    }
    nloc = mine > 0u ? mine : 1u; nx = cnt > 0u ? cnt : 1u;
}

__device__ __forceinline__ void xcd_barrier(const XcdBarrier& b) {
    asm volatile("s_waitcnt vmcnt(0)" ::: "memory");
    __syncthreads();
    if (threadIdx.x == 0) {
        unsigned* bar = b.bar;
        __builtin_amdgcn_s_waitcnt(0);
        unsigned nloc = b.st[0], nx = b.st[1];
        if (nloc == 0u) { xcd_barrier_complete(bar, b.x, nloc, nx); b.st[0] = nloc; b.st[1] = nx; }
        const unsigned old = xb_add(&bar[XB_XSUB(b.x)], 1u);
        const unsigned gen = old / nloc;
        if (old + 1u == (gen + 1u) * nloc) {
            __builtin_amdgcn_fence(__ATOMIC_RELEASE, "agent");
            asm volatile("s_waitcnt vmcnt(0)" ::: "memory");
            const unsigned og = xb_add(&bar[XB_TOP], 1u);
            const unsigned tg = og / nx;
            if (og + 1u == (tg + 1u) * nx) xb_add(&bar[XB_TOPGEN], 1u);
            else XB_SPIN(xb_ld(&bar[XB_TOPGEN]) == tg, bar);
            __builtin_amdgcn_fence(__ATOMIC_ACQUIRE, "agent");
            xb_add(&bar[XB_XGEN(b.x)], 1u);
            asm volatile("s_waitcnt vmcnt(0)" ::: "memory");
        } else {
            XB_SPIN(xb_ld(&bar[XB_XGEN(b.x)]) == gen, bar);
            __builtin_amdgcn_fence(__ATOMIC_ACQUIRE, "agent");
            asm volatile("s_waitcnt vmcnt(0)" ::: "memory");
        }
    }
    __syncthreads();
}

struct Args { const float* in[19]; float* out; unsigned char* ws; int ph_lo, ph_hi; };

__global__ void __launch_bounds__(512, 2) mega_fwd(Args args) {
    extern __shared__ __attribute__((aligned(16))) unsigned char lds_raw[];
    LAS unsigned char* lds = (LAS unsigned char*)lds_raw;
    cg::grid_group grid = cg::this_grid();
    const int tid = threadIdx.x; const int wave = __builtin_amdgcn_readfirstlane(tid >> 6);
#define LANE_LOCAL() int lane = threadIdx.x; asm volatile("" : "+v"(lane)); lane &= 63
    const int G = gridDim.x, bx = blockIdx.x; const int vcu = (G % 8 == 0) ? (bx % 8) * (G / 8) + bx / 8 : bx;
    unsigned char* ws = args.ws;
    float* SS = (float*)(ws + WS_SS); float* CS = (float*)(ws + WS_CS);
    bf16* WGU1 = (bf16*)(ws + WS_WGU1); bf16* WD1 = (bf16*)(ws + WS_WD1); bf16* WIN = (bf16*)(ws + WS_WIN); bf16* WOUT = (bf16*)(ws + WS_WOUT); bf16* WGU2 = (bf16*)(ws + WS_WGU2); bf16* WD2 = (bf16*)(ws + WS_WD2);
    bf16* XB = (bf16*)(ws + WS_XB); bf16* MIX = (bf16*)(ws + WS_MIX); bf16* HP = (bf16*)(ws + WS_HP);
    const float* x = args.in[0]; float* out = args.out;
    const int lo = args.ph_lo, hi_ = args.ph_hi;
    if (tid < 16) ((LAS unsigned*)(lds + LDS_MISC))[tid] = 0u;
    __syncthreads();
    XcdBarrier xbar = xcd_barrier_post((unsigned*)(ws + WS_BAR), (volatile LAS unsigned*)(lds + LDS_MISC));
#ifndef PH_MASK
#define PH_MASK 0x1ff
#endif
#define IN(k) (((PH_MASK >> (k)) & 1) && lo <= (k) && (k) < hi_)
#ifndef REP_MASK
#define REP_MASK 0
#endif
#define REPS(k) for (int rep_ = 0; rep_ < 1 + ((REP_MASK >> (k)) & 1); ++rep_)
#define SEAM(k) do { if (IN(k) && IN((k) + 1)) { if ((k) == 0 && hi_ > 64) grid.sync(); else xcd_barrier(xbar); } } while (0)

    if (IN(0)) REPS(0) {
        LANE_LOCAL();
        LAS float* scr = (LAS float*)(lds + wave * 16384);
        const int gw = vcu * 8 + wave, NGW = G * 8;
        constexpr int I_GU = (DM / 64) * (DFF / 32), I_D = (DFF / 64) * (DM / 32), I_IN = (DM / 64) * (INC / 32), I_OUT = (DM / 64) * (DM / 32);
        constexpr int NITEMS = 4 * I_GU + 2 * I_D + I_IN + I_OUT;
        for (int it = gw; it < NITEMS; it += NGW) {
            int r = it;
            if (r < I_GU) { p0_transpose_item(args.in[3], args.in[2], DM, DFF, WGU1, 1, scr, r, lane); continue; } r -= I_GU;
            if (r < I_GU) { p0_transpose_item(args.in[4], args.in[2], DM, DFF, WGU1, 2, scr, r, lane); continue; } r -= I_GU;
            if (r < I_D) { p0_transpose_item(args.in[5], nullptr, DFF, DM, WD1, 0, scr, r, lane); continue; } r -= I_D;
            if (r < I_IN) { p0_transpose_item(args.in[7], args.in[6], DM, INC, WIN, 0, scr, r, lane); continue; } r -= I_IN;
            if (r < I_OUT) { p0_transpose_item(args.in[13], nullptr, DM, DM, WOUT, 0, scr, r, lane); continue; } r -= I_OUT;
            if (r < I_GU) { p0_transpose_item(args.in[15], args.in[14], DM, DFF, WGU2, 1, scr, r, lane); continue; } r -= I_GU;
            if (r < I_GU) { p0_transpose_item(args.in[16], args.in[14], DM, DFF, WGU2, 2, scr, r, lane); continue; } r -= I_GU;
            p0_transpose_item(args.in[17], nullptr, DFF, DM, WD2, 0, scr, r, lane);
        }
        for (int m = gw; m < M; m += NGW) {
            const f32x4* xr = (const f32x4*)(x + (size_t)m * DM) + lane; f32x4 v[4]; float s = 0.f;
#pragma unroll
            for (int j = 0; j < 4; ++j) { v[j] = __builtin_nontemporal_load(xr + 64 * j); s += (v[j].x * v[j].x + v[j].y * v[j].y) + (v[j].z * v[j].z + v[j].w * v[j].w); }
            s = wave_sum(s);
            unsigned long long* o8 = (unsigned long long*)(XB + (size_t)m * DM) + lane;
#pragma unroll
            for (int j = 0; j < 4; ++j) o8[64 * j] = (unsigned long long)pk2(v[j].x, v[j].y) | ((unsigned long long)pk2(v[j].z, v[j].w) << 32);
            if (lane < 16) SS[(size_t)m * 16 + lane] = lane == 0 ? s : 0.f;
        }
        const int* pos = (const int*)args.in[1];
        for (int i = (vcu * 512 + tid); i < M * 8; i += G * 512) {
            const int row = i >> 3, f = i & 7;
            float a = -13.122363377404328f * (float)f; a = a * 2.0f; a = a / 16.0f;
            const float inv = expf(a), ang = (float)pos[row] * inv;
            float sn, cn; sincosf(ang, &sn, &cn);
            CS[(size_t)row * 16 + f] = cn; CS[(size_t)row * 16 + 8 + f] = sn;
        }
    }
    SEAM(0);
    if (IN(1)) REPS(1) {
        pg8::Gemm g{XB, WGU1, M, 2 * DFF, DM}; pg8::StaticOrder S; S.init(M, 2 * DFF, G, bx);
        pg8::EpiSwiGLU E{HP, SS, lds};
        pg8::gemm_phase<pg8::EpiSwiGLU, pg8::StaticOrder, true, true>(lds, g, S, E);
    }
    SEAM(1);
    if (IN(2)) {
        pg8::Gemm g{HP, WD1, M, DM, DFF}; pg8::StaticOrder S; S.init(M, DM, G, bx);
        pg8::EpiRes E{XB, SS, 0.5f};
        pg8::gemm_phase<pg8::EpiRes, pg8::StaticOrder, true, true>(lds, g, S, E);
    }
    SEAM(2);
    if (IN(3)) REPS(3) {
        pg8::Gemm g{XB, WIN, M, INC, DM}; pg8::StaticOrder S; S.init(M, INC, G, bx);
        pg8::EpiProj E{HP, SS, CS, C2, lds};
        pg8::gemm_phase<pg8::EpiProj, pg8::StaticOrder, true, true>(lds, g, S, E);
    }
    SEAM(3);
    if (IN(4)) REPS(4) {
        float lam;
        { LANE_LOCAL(); const float a = wave_sum(args.in[8][lane] * args.in[9][lane]), b2 = wave_sum(args.in[10][lane] * args.in[11][lane]); lam = expf(a) - expf(b2) + 0.2f; }
        int it = 0;
#ifndef NO_DIL
        for (int v = vcu; v < 256; v += G) {
            const int bh = v >> 1, c0 = v & 1;
            dil_unit(HP, MIX, bh >> 3, bh & 7, 3 - c0, lds);
            dil_unit(HP, MIX, bh >> 3, bh & 7, c0, lds);
        }
#endif
        __syncthreads();
#ifndef NO_DIFF
        for (int p = vcu; p < 256; p += G) {
            const int b = p >> 4, h = (p >> 2) & 3, s = p & 3;
            diff_unit(HP, MIX, args.in[12], lam, b, h, 7 - s, lds, it);
            diff_unit(HP, MIX, args.in[12], lam, b, h, s, lds, it);
        }
#endif
    }
    SEAM(4);
    if (IN(5)) {
        pg8::Gemm g{MIX, WOUT, M, DM, DM}; pg8::StaticOrder S; S.init(M, DM, G, bx);
        pg8::EpiRes E{XB, SS, 1.0f};
        pg8::gemm_phase<pg8::EpiRes, pg8::StaticOrder, true, true>(lds, g, S, E);
    }
    SEAM(5);
    if (IN(6)) {
        pg8::Gemm g{XB, WGU2, M, 2 * DFF, DM}; pg8::StaticOrder S; S.init(M, 2 * DFF, G, bx);
        pg8::EpiSwiGLU E{HP, SS, lds};
        pg8::gemm_phase<pg8::EpiSwiGLU, pg8::StaticOrder, true, true>(lds, g, S, E);
    }
    SEAM(6);
    if (IN(7)) {
        pg8::Gemm g{HP, WD2, M, DM, DFF}; pg8::StaticOrder S; S.init(M, DM, G, bx);
        pg8::EpiFinal E{XB, out, args.in[18], (unsigned*)SS, (unsigned*)(ws + WS_BAR) + 4096, lds + 131072, 0.5f};
        pg8::gemm_phase<pg8::EpiFinal, pg8::StaticOrder, true, true>(lds, g, S, E);
    }
#undef IN
#undef SEAM
}

#ifndef MK_N_LAUNCHES
#define MK_N_LAUNCHES 1
#endif
extern "C" void kernel_launch(void* const* d_in, const int* in_sizes, int n_in, void* d_out, int out_size, void* d_ws, size_t ws_size, hipStream_t stream) {
    static int grid = 0;
    if (grid == 0) {
        if (n_in != 19 || in_sizes[0] != M * DM || out_size != M * DM || ws_size < WS_END) { fprintf(stderr, "kernel_launch: unexpected shapes (n_in %d, ws %zu)\n", n_in, ws_size); grid = -1; return; }
        int dev = 0, cus = 0, per_cu = 0;
        hipGetDevice(&dev); hipDeviceGetAttribute(&cus, hipDeviceAttributeMultiprocessorCount, dev);
        if (hipFuncSetAttribute((const void*)mega_fwd, hipFuncAttributeMaxDynamicSharedMemorySize, LDS_BYTES) != hipSuccess) { fprintf(stderr, "kernel_launch: hipFuncSetAttribute failed\n"); grid = -1; return; }
        if (hipOccupancyMaxActiveBlocksPerMultiprocessor(&per_cu, (const void*)mega_fwd, 512, LDS_BYTES) != hipSuccess || per_cu < 1) { fprintf(stderr, "kernel_launch: occupancy query says %d\n", per_cu); grid = -1; (void)hipGetLastError(); return; }
        grid = cus;
    }
    if (grid < 0) return;
    Args a{};
    for (int i = 0; i < 19; ++i) a.in[i] = (const float*)d_in[i];
    a.out = (float*)d_out; a.ws = (unsigned char*)d_ws;
#if MK_N_LAUNCHES == 1
    if (hipMemsetAsync((char*)d_ws + WS_BAR, 0, BAR_BYTES, stream) != hipSuccess) { fprintf(stderr, "kernel_launch: memset failed\n"); return; }
    a.ph_lo = 0; a.ph_hi = 8;
    void* kargs[] = {&a};
    hipError_t e = hipLaunchCooperativeKernel((const void*)mega_fwd, dim3(grid), dim3(512), kargs, LDS_BYTES, stream);
    if (e != hipSuccess) fprintf(stderr, "kernel_launch: cooperative launch failed: %s (grid %d)\n", hipGetErrorString(e), grid);
#else
    for (int p = 0; p < 8; ++p) { a.ph_lo = p; a.ph_hi = p + 1; hipLaunchKernelGGL(mega_fwd, dim3(grid), dim3(512), LDS_BYTES, stream, a); }
#endif
}
```
